# Optimizing an MI355X kernel written in HIP

```python
import jax, jax.numpy as jnp
from jax import lax
import numpy as np

D_MODEL = 1024
BATCH = 8
SEQ = 2048
DEPTH = 2
DEC_BATCH = 32
DEC_SEQ = 4
PAST_LEN = 8192
PAGE_SIZE = 128

HEAD_DIM = 64
MIX_WIDTH = D_MODEL
SGU_WIDTH = MIX_WIDTH // 4
SGU_GROUPS = 4
SGU_GROUP_DIM = SGU_WIDTH // SGU_GROUPS
ATT_WIDTH = MIX_WIDTH - SGU_WIDTH
N_ATT_HEADS = ATT_WIDTH // HEAD_DIM
DIL_PATTERNS = ((128, 1), (512, 4), (2048, 16))
HEADS_PER_PATTERN = N_ATT_HEADS // len(DIL_PATTERNS)
ROT_DIM = HEAD_DIM // 4
ROPE_THETA = 500000.0
CHUNK = 128
QBLOCK = 128
N_MEM = 256
MEM_HEADS = 4
MEM_HEAD_DIM = D_MODEL // MEM_HEADS
D_FF = 4 * D_MODEL
IN_COLS = 3 * ATT_WIDTH + 2 * SGU_WIDTH
DEEPNORM_ALPHA = (2 * DEPTH) ** 0.25
DEEPNORM_BETA = (8 * DEPTH) ** -0.25
LN_EPS = 1e-5
NEG = -1e30

kernel_name = 'hymba_style_dilated_attn_chunk_sgu_deepnorm_step'


def layer_norm(x, g, b):
    xf = x.astype(jnp.float32)
    mu = jnp.mean(xf, -1, keepdims=True)
    var = jnp.mean(jnp.square(xf - mu), -1, keepdims=True)
    y = (xf - mu) * lax.rsqrt(var + LN_EPS) * g.astype(jnp.float32) + b.astype(jnp.float32)
    return y.astype(x.dtype)


def rope_partial(x, pos):
    half = ROT_DIM // 2
    inv = ROPE_THETA ** (-jnp.arange(half, dtype=jnp.float32) / half)
    ang = pos.astype(jnp.float32)[:, None] * inv[None, :]
    cos = jnp.cos(ang)[None, :, None, :]
    sin = jnp.sin(ang)[None, :, None, :]
    xr = x[..., :ROT_DIM].astype(jnp.float32)
    x1, x2 = xr[..., :half], xr[..., half:]
    rot = jnp.concatenate([x1 * cos - x2 * sin, x2 * cos + x1 * sin], -1)
    return jnp.concatenate([rot.astype(x.dtype), x[..., ROT_DIM:]], -1)


def dilated_window_attention(q, k_all, v_all, n_prefix, window, dilation):
    B, T, H, Dh = q.shape
    qb = min(T, QBLOCK)
    nb = T // qb
    dist = dilation * jnp.arange(window // dilation + 1)
    scale = HEAD_DIM ** -0.5
    q_blocks = jnp.moveaxis(q.reshape(B, nb, qb, H, Dh), 1, 0)

    def block(args):
        qc, c = args
        rows = n_prefix + c * qb + jnp.arange(qb)
        idx = rows[:, None] - dist[None, :]
        valid = idx >= 0
        idx = jnp.maximum(idx, 0)
        kg = jnp.take(k_all, idx, axis=1)
        vg = jnp.take(v_all, idx, axis=1)
        s = jnp.einsum('bqhd,bqjhd->bqhj', qc, kg).astype(jnp.float32) * scale
        s = jnp.where(valid[None, :, None, :], s, NEG)
        m = jnp.max(s, -1, keepdims=True)
        pr = jnp.exp(s - m)
        den = jnp.sum(pr, -1)
        o = jnp.einsum('bqhj,bqjhd->bqhd', pr, vg.astype(jnp.float32)) / den[..., None]
        return o, m[..., 0] + jnp.log(den)

    o, lse = lax.map(block, (q_blocks, jnp.arange(nb)))
    o = jnp.moveaxis(o, 0, 1).reshape(B, T, H, Dh)
    lse = jnp.moveaxis(lse, 0, 1).reshape(B, T, H)
    return o, lse


def chunk_spatial_gate(u, v, w_s, b_s):
    B, T, _ = u.shape
    c = min(T, CHUNK)
    n = T // c
    mask = jnp.tril(jnp.ones((c, c), dtype=bool))
    w = jnp.where(mask[None], w_s[:, :c, :c], 0.0).astype(v.dtype)
    vr = v.reshape(B, n, c, SGU_GROUPS, SGU_GROUP_DIM)
    mixed = jnp.einsum('gts,bnsgd->bntgd', w, vr) + b_s[:, :c].T[None, None, :, :, None]
    return u * mixed.reshape(B, T, SGU_WIDTH).astype(u.dtype)


def decoder_layer(x, pos, past_kv, mem_k, mem_v, p):
    B, T, _ = x.shape
    proj = x @ p['w_in']
    a = ATT_WIDTH
    q = rope_partial(proj[..., :a].reshape(B, T, N_ATT_HEADS, HEAD_DIM), pos)
    k = rope_partial(proj[..., a:2 * a].reshape(B, T, N_ATT_HEADS, HEAD_DIM), pos)
    v = proj[..., 2 * a:3 * a].reshape(B, T, N_ATT_HEADS, HEAD_DIM)
    u = jax.nn.gelu(proj[..., 3 * a:3 * a + SGU_WIDTH])
    gate_in = jax.nn.gelu(proj[..., 3 * a + SGU_WIDTH:])

    outs, lses, win_rows = [], [], []
    for gi, (win, dil) in enumerate(DIL_PATTERNS):
        hs = slice(gi * HEADS_PER_PATTERN, (gi + 1) * HEADS_PER_PATTERN)
        new_kv = jnp.stack([k[:, :, hs], v[:, :, hs]], axis=2)
        if past_kv is None:
            kv_all = new_kv
            n_prefix = 0
            win_rows.append(new_kv[:, T - min(win, T):])
        else:
            past = past_kv[gi].astype(new_kv.dtype)
            kv_all = jnp.concatenate([past, new_kv], axis=1)
            n_prefix = past.shape[1]
            win_rows.append(new_kv)
        o, lse = dilated_window_attention(q[:, :, hs], kv_all[:, :, 0], kv_all[:, :, 1], n_prefix, win, dil)
        outs.append(o)
        lses.append(lse)
    mixw = jax.nn.softmax(jnp.stack(lses, 0), axis=0)
    att = jnp.concatenate([mixw[i][..., None] * outs[i] for i in range(len(DIL_PATTERNS))], axis=2)
    att = att.reshape(B, T, ATT_WIDTH).astype(x.dtype)

    gv = layer_norm(gate_in, p['sgu_ln_g'], p['sgu_ln_b'])
    sgu = chunk_spatial_gate(u, gv, p['w_spatial'], p['b_spatial'])

    mixed = jnp.concatenate([att, sgu], -1) @ p['w_mix_out']
    x = layer_norm(DEEPNORM_ALPHA * x + mixed, p['ln1_g'], p['ln1_b'])

    qx = (x @ p['w_xq']).reshape(B, T, MEM_HEADS, MEM_HEAD_DIM)
    s = jnp.einsum('bthd,bmhd->bhtm', qx, mem_k).astype(jnp.float32) * MEM_HEAD_DIM ** -0.5
    pr = jax.nn.softmax(s, axis=-1)
    ox = jnp.einsum('bhtm,bmhd->bthd', pr, mem_v.astype(jnp.float32)).reshape(B, T, D_MODEL).astype(x.dtype)
    x = layer_norm(DEEPNORM_ALPHA * x + ox @ p['w_xo'], p['ln2_g'], p['ln2_b'])

    h = jnp.square(jax.nn.relu(x @ p['w_up']))
    x = layer_norm(DEEPNORM_ALPHA * x + h @ p['w_down'], p['ln3_g'], p['ln3_b'])
    return x, win_rows, gv


def setup_inputs(seed: int = 0) -> dict:
    key = jax.random.key(seed)
    ks = jax.random.split(key, 32)
    f32 = jnp.float32

    def nrm(k, shape, scale=1.0):
        return jax.random.normal(k, shape, f32) * scale

    hg = HEADS_PER_PATTERN
    inp = {}
    inp['x_prompt'] = nrm(ks[0], (BATCH, SEQ, D_MODEL))
    inp['x_sample'] = nrm(ks[1], (DEC_BATCH, DEC_SEQ, D_MODEL))
    inp['cache_kv_w128'] = nrm(ks[2], (DEPTH, DEC_BATCH, min(128, PAST_LEN), 2, hg, HEAD_DIM))
    inp['cache_kv_w512'] = nrm(ks[3], (DEPTH, DEC_BATCH, min(512, PAST_LEN), 2, hg, HEAD_DIM))
    inp['cache_kv_w2048'] = nrm(ks[4], (DEPTH, DEC_BATCH, min(2048, PAST_LEN), 2, hg, HEAD_DIM))
    inp['cache_mem_kv'] = nrm(ks[5], (DEPTH, DEC_BATCH, N_MEM, 2, MEM_HEADS, MEM_HEAD_DIM))
    inp['mem_prompt'] = nrm(ks[6], (BATCH, N_MEM, D_MODEL))
    inp['w_in'] = nrm(ks[7], (DEPTH, D_MODEL, IN_COLS), D_MODEL ** -0.5)
    inp['sgu_ln_g'] = 1.0 + nrm(ks[8], (DEPTH, SGU_WIDTH), 0.01)
    inp['sgu_ln_b'] = nrm(ks[9], (DEPTH, SGU_WIDTH), 0.01)
    inp['w_spatial'] = nrm(ks[10], (DEPTH, SGU_GROUPS, CHUNK, CHUNK), CHUNK ** -0.5)
    inp['b_spatial'] = 1.0 + nrm(ks[11], (DEPTH, SGU_GROUPS, CHUNK), 0.01)
    inp['w_mix_out'] = nrm(ks[12], (DEPTH, MIX_WIDTH, D_MODEL), DEEPNORM_BETA * MIX_WIDTH ** -0.5)
    inp['ln1_g'] = 1.0 + nrm(ks[13], (DEPTH, D_MODEL), 0.01)
    inp['ln1_b'] = nrm(ks[14], (DEPTH, D_MODEL), 0.01)
    inp['w_xq'] = nrm(ks[15], (DEPTH, D_MODEL, D_MODEL), D_MODEL ** -0.5)
    inp['w_xkv'] = nrm(ks[16], (DEPTH, D_MODEL, 2 * D_MODEL), D_MODEL ** -0.5)
    inp['w_xo'] = nrm(ks[17], (DEPTH, D_MODEL, D_MODEL), DEEPNORM_BETA * D_MODEL ** -0.5)
    inp['ln2_g'] = 1.0 + nrm(ks[18], (DEPTH, D_MODEL), 0.01)
    inp['ln2_b'] = nrm(ks[19], (DEPTH, D_MODEL), 0.01)
    inp['w_up'] = nrm(ks[20], (DEPTH, D_MODEL, D_FF), D_MODEL ** -0.5)
    inp['w_down'] = nrm(ks[21], (DEPTH, D_FF, D_MODEL), DEEPNORM_BETA * D_FF ** -0.5)
    inp['ln3_g'] = 1.0 + nrm(ks[22], (DEPTH, D_MODEL), 0.01)
    inp['ln3_b'] = nrm(ks[23], (DEPTH, D_MODEL), 0.01)
    return inp


def reference(x_prompt, x_sample, cache_kv_w128, cache_kv_w512, cache_kv_w2048, cache_mem_kv, mem_prompt,
              w_in, sgu_ln_g, sgu_ln_b, w_spatial, b_spatial, w_mix_out, ln1_g, ln1_b,
              w_xq, w_xkv, w_xo, ln2_g, ln2_b, w_up, w_down, ln3_g, ln3_b):
    pos_p = jnp.arange(x_prompt.shape[1], dtype=jnp.int32)
    pos_s = PAST_LEN + jnp.arange(x_sample.shape[1], dtype=jnp.int32)
    hp, hs = x_prompt, x_sample
    rows_p = [[], [], []]
    rows_s = [[], [], []]
    mem_p = []
    chunk_v = []
    for l in range(DEPTH):
        p = {'w_in': w_in[l], 'sgu_ln_g': sgu_ln_g[l], 'sgu_ln_b': sgu_ln_b[l],
             'w_spatial': w_spatial[l], 'b_spatial': b_spatial[l], 'w_mix_out': w_mix_out[l],
             'ln1_g': ln1_g[l], 'ln1_b': ln1_b[l], 'w_xq': w_xq[l], 'w_xo': w_xo[l],
             'ln2_g': ln2_g[l], 'ln2_b': ln2_b[l], 'w_up': w_up[l], 'w_down': w_down[l],
             'ln3_g': ln3_g[l], 'ln3_b': ln3_b[l]}
        mkv = (mem_prompt @ w_xkv[l]).reshape(mem_prompt.shape[0], mem_prompt.shape[1], 2, MEM_HEADS, MEM_HEAD_DIM)
        mem_p.append(mkv)
        hp, wp, _ = decoder_layer(hp, pos_p, None, mkv[:, :, 0], mkv[:, :, 1], p)
        hs, ws, gvs = decoder_layer(hs, pos_s, (cache_kv_w128[l], cache_kv_w512[l], cache_kv_w2048[l]),
                                    cache_mem_kv[l, :, :, 0], cache_mem_kv[l, :, :, 1], p)
        for gi in range(len(DIL_PATTERNS)):
            rows_p[gi].append(wp[gi])
            rows_s[gi].append(ws[gi])
        chunk_v.append(gvs)
    return (hp, hs,
            jnp.stack(rows_p[0]), jnp.stack(rows_p[1]), jnp.stack(rows_p[2]), jnp.stack(mem_p),
            jnp.stack(rows_s[0]), jnp.stack(rows_s[1]), jnp.stack(rows_s[2]), jnp.stack(chunk_v))
```

```cpp
#include <hip/hip_runtime.h>
#include <hip/hip_cooperative_groups.h>
#include <cstdio>
#include <cstdint>
namespace cg = cooperative_groups;

#ifndef MK_MULTI
#define MK_MULTI 0
#endif

#define LAS __attribute__((address_space(3)))
typedef unsigned short bf16_t;
typedef short bf16x8 __attribute__((ext_vector_type(8)));
typedef short s16x4 __attribute__((ext_vector_type(4)));
typedef float f32x4 __attribute__((ext_vector_type(4)));
typedef unsigned u32x4 __attribute__((ext_vector_type(4)));
typedef unsigned u32x2 __attribute__((ext_vector_type(2)));

constexpr int DM = 1024, SEQ = 2048, NB = 8, DEPTH = 2, DECB = 32, DECS = 4;
constexpr int MP = NB * SEQ;
constexpr int MS = DECB * DECS;
constexpr int MR = MP + MS;
constexpr int MT = 16640;
constexpr int INC = 2816, ATT = 768, FF = 4096, NMEM = 256;
constexpr float LN_EPS = 1e-5f;
constexpr float ALPHA = 1.41421356237309515f;
constexpr float LOG2E = 1.4426950408889634f, LN2 = 0.6931471805599453f;
constexpr float QSCALE = 0.125f * LOG2E;
constexpr float XQSCALE = 0.0625f * LOG2E;

constexpr size_t O0 = 0, O1 = 16777216, O2 = 16908288, O3 = 17956864, O4 = 22151168, O5 = 38928384,
                 O6 = 47316992, O7 = 47448064, O8 = 47579136, O9 = 47710208;

constexpr size_t al256(size_t x) { return (x + 255) & ~(size_t)255; }
constexpr size_t WS_BAR = 0, WS_BAR_BYTES = 16384;
constexpr size_t WS_ROPE = 16384;
constexpr size_t WS_WIN = al256(WS_ROPE + 2052 * 16 * 4);
constexpr size_t WS_WMIX = WS_WIN + (size_t)DEPTH * INC * DM * 2;
constexpr size_t WS_WXQ = WS_WMIX + (size_t)DEPTH * DM * DM * 2;
constexpr size_t WS_WXKV = WS_WXQ + (size_t)DEPTH * DM * DM * 2;
constexpr size_t WS_WXO = WS_WXKV + (size_t)DEPTH * 2 * DM * DM * 2;
constexpr size_t WS_WUP = WS_WXO + (size_t)DEPTH * DM * DM * 2;
constexpr size_t WS_WDN = WS_WUP + (size_t)DEPTH * FF * DM * 2;
constexpr size_t WS_WSP = WS_WDN + (size_t)DEPTH * FF * DM * 2;
constexpr size_t WS_MEMB = WS_WSP + (size_t)DEPTH * 4 * 128 * 128 * 2;
constexpr size_t WS_MKV = WS_MEMB + (size_t)2048 * DM * 2;
constexpr size_t WS_CV = WS_MKV + (size_t)DEPTH * 2048 * 2048 * 2;
constexpr size_t WS_CVP = WS_CV + (size_t)DEPTH * 3 * 2 * 4096 * 4;
constexpr size_t WS_STM = WS_CVP + (size_t)DEPTH * 3 * 16 * 2 * 4096 * 4;
constexpr size_t WS_STS = WS_STM + (size_t)2 * MP * 32 * 4;
constexpr size_t WS_GST = WS_STS + (size_t)2 * 128 * 128 * 4;
constexpr size_t WS_ZB = WS_GST + (size_t)MP * 8 * 4;
constexpr size_t WS_XB = WS_ZB + (size_t)MT * DM * 2;
constexpr size_t WS_Q = WS_XB + (size_t)MT * DM * 2;
constexpr size_t WS_K = WS_Q + (size_t)MT * ATT * 2;
constexpr size_t WS_V = WS_K + (size_t)MT * ATT * 2;
constexpr size_t WS_U = WS_V + (size_t)MT * ATT * 2;
constexpr size_t WS_G = WS_U + (size_t)MT * 256 * 2;
constexpr size_t WS_CAT = WS_G + (size_t)MT * 256 * 2;
constexpr size_t WS_LSE = WS_CAT + (size_t)MT * DM * 2;
constexpr size_t WS_XQ = WS_LSE + (size_t)MT * 16 * 4;
constexpr size_t WS_XO = WS_XQ + (size_t)MT * DM * 2;
constexpr size_t WS_H = WS_XO + (size_t)MT * DM * 2;
constexpr size_t WS_END = WS_H + (size_t)MT * FF * 2;

constexpr int LDS_BYTES = 147456;
constexpr int NWAVES = 8;

__device__ __forceinline__ unsigned f2bf(float f) { unsigned u = __builtin_bit_cast(unsigned, f); return (u + 0x7fffu + ((u >> 16) & 1u)) >> 16; }
typedef float f32x2_t __attribute__((ext_vector_type(2))); typedef __bf16 bf16x2_t __attribute__((ext_vector_type(2)));
__device__ __forceinline__ unsigned pk2(float lo, float hi) { const f32x2_t v = {lo, hi}; const bf16x2_t b = __builtin_convertvector(v, bf16x2_t); return __builtin_bit_cast(unsigned, b); }
__device__ __forceinline__ float bf2f(unsigned short h) { return __builtin_bit_cast(float, (unsigned)h << 16); }
__device__ __forceinline__ float bflo(unsigned u) { return __builtin_bit_cast(float, u << 16); }
__device__ __forceinline__ float bfhi(unsigned u) { return __builtin_bit_cast(float, u & 0xffff0000u); }
__device__ __forceinline__ u32x2 pk4(f32x4 v) { u32x2 r; r.x = pk2(v.x, v.y); r.y = pk2(v.z, v.w); return r; }
__device__ __forceinline__ float wave_sum(float v) {
#pragma unroll
    for (int o = 1; o < 64; o <<= 1) v += __shfl_xor(v, o);
    return v;
}
__device__ __forceinline__ float gelu_tanh(float x) {
    const float t = x * (2.302208198f + 0.1029432397f * x * x);
    const float e = __builtin_amdgcn_exp2f(fminf(t, 80.f));
    return x - x * __builtin_amdgcn_rcpf(1.f + e);
}
__device__ __forceinline__ int lane_id_v() { int l; asm volatile("v_mbcnt_lo_u32_b32 %0, -1, 0\n\tv_mbcnt_hi_u32_b32 %0, -1, %0" : "=v"(l)); return l; }
#define LDS_WAIT() asm volatile("s_waitcnt lgkmcnt(0)" ::: "memory")
#define VM_WAIT() asm volatile("s_waitcnt vmcnt(0)" ::: "memory")
__device__ __forceinline__ s16x4 vtr(const LAS unsigned char* p) {
    return __builtin_bit_cast(s16x4, __builtin_amdgcn_ds_read_tr16_b64_v4i16((LAS s16x4*)p));
}


#define XB_TMO      128
#define XB_XCNT(j)  (256  + 64 * (j))
#define XB_XSUB(j)  (1280 + 64 * (j))
#define XB_XGEN(j)  (2304 + 64 * (j))
#define XB_TOP      3328
#define XB_TOPGEN   3392
#define XCD_BAR_WORDS 3456
#define XB_SPIN_CAP (1u << 22)
__device__ __forceinline__ unsigned xb_ld(unsigned* p)              { return __hip_atomic_load(p, __ATOMIC_RELAXED, __HIP_MEMORY_SCOPE_AGENT); }
__device__ __forceinline__ unsigned xb_add(unsigned* p, unsigned v) { return __hip_atomic_fetch_add(p, v, __ATOMIC_RELAXED, __HIP_MEMORY_SCOPE_AGENT); }
__device__ __forceinline__ unsigned xb_xcc_id() { return (unsigned)__builtin_amdgcn_s_getreg((3 << 11) | 20) & 0xFu; }
#define XB_SPIN(cond, bar) do { unsigned _sp = 0; while (cond) { __builtin_amdgcn_s_sleep(1); \
    if ((++_sp & 255u) == 0u) { if (xb_ld(&(bar)[XB_TMO])) break; if (_sp > XB_SPIN_CAP) { atomicAdd(&(bar)[XB_TMO], 1u); break; } } } } while (0)
struct XcdBarrier { unsigned* bar; unsigned x; volatile LAS unsigned* st; };
__device__ __forceinline__ XcdBarrier xcd_barrier_post(unsigned* bar, volatile LAS unsigned* st, int wave) {
    XcdBarrier b; b.bar = bar; b.x = xb_xcc_id(); b.st = st;
    if (wave == 0 && lane_id_v() == 0) (void)xb_add(&bar[XB_XCNT(b.x)], 1u);
    return b;
}
__device__ __forceinline__ void xcd_barrier_complete(unsigned* bar, unsigned x, unsigned& nloc, unsigned& nx) {
    const unsigned G = gridDim.x * gridDim.y * gridDim.z;
    unsigned sum, cnt, mine, sp = 0u;
    for (;;) {
        sum = 0u; cnt = 0u; mine = 0u;
#pragma unroll
        for (unsigned j = 0; j < 16; ++j) { const unsigned c = xb_ld(&bar[XB_XCNT(j)]); sum += c; cnt += (c > 0u) ? 1u : 0u; mine = (j == x) ? c : mine; }
        if (sum == G) break;
        __builtin_amdgcn_s_sleep(1);
        if ((++sp & 255u) == 0u) { if (xb_ld(&bar[XB_TMO])) break; if (sp > XB_SPIN_CAP) { atomicAdd(&bar[XB_TMO], 1u); break; } }
    }
    nloc = mine > 0u ? mine : 1u; nx = cnt > 0u ? cnt : 1u;
}
__device__ __forceinline__ void xcd_barrier(const XcdBarrier& b, int wave) {
    asm volatile("s_waitcnt vmcnt(0)" ::: "memory");
    __syncthreads();
    if (wave == 0 && lane_id_v() == 0) {
        unsigned* bar = b.bar;
        __builtin_amdgcn_s_waitcnt(0);
        unsigned nloc = b.st[0], nx = b.st[1];
        if (nloc == 0u) { xcd_barrier_complete(bar, b.x, nloc, nx); b.st[0] = nloc; b.st[1] = nx; }
        const unsigned old = xb_add(&bar[XB_XSUB(b.x)], 1u);
        const unsigned gen = old / nloc;
        if (old + 1u == (gen + 1u) * nloc) {
            __builtin_amdgcn_fence(__ATOMIC_RELEASE, "agent");
            asm volatile("s_waitcnt vmcnt(0)" ::: "memory");
            const unsigned og = xb_add(&bar[XB_TOP], 1u);
            const unsigned tg = og / nx;
            if (og + 1u == (tg + 1u) * nx) xb_add(&bar[XB_TOPGEN], 1u);
            else XB_SPIN(xb_ld(&bar[XB_TOPGEN]) == tg, bar);
            __builtin_amdgcn_fence(__ATOMIC_ACQUIRE, "agent");
            xb_add(&bar[XB_XGEN(b.x)], 1u);
            asm volatile("s_waitcnt vmcnt(0)" ::: "memory");
        } else {
            XB_SPIN(xb_ld(&bar[XB_XGEN(b.x)]) == gen, bar);
            __builtin_amdgcn_fence(__ATOMIC_ACQUIRE, "agent");
            asm volatile("s_waitcnt vmcnt(0)" ::: "memory");
        }
    }
    __syncthreads();
}

namespace pg8 {
constexpr int BM = 256, BK = 64, HALF = 128, HTB = HALF * BK * 2, NXCD = 8, WGM = 8;
__host__ __device__ __forceinline__ int lds_byte(int r, int c) { const int st = (r >> 4) * 2 + (c >> 5), rr = r & 15, cc = c & 31, ob = rr * 64 + cc * 2; return st * 1024 + (ob ^ (((ob >> 9) & 1) << 5)); }
__host__ __device__ __forceinline__ void stage_rc(int b, int& R, int& C) { const int st = b / 1024, sb = b % 1024, swz = sb ^ (((sb >> 9) & 1) << 5); R = (st >> 1) * 16 + swz / 64; C = (st & 1) * 32 + (swz % 64) / 2; }
struct Unit { int pm, pn; };
struct Gemm { const bf16_t* A; const bf16_t* Bt; int M, N, K; };
struct StaticOrder {
    int nM, nN, nwg, G, c;
    __host__ __device__ void init(int M, int N, int G_, int c_) { nM = M / BM; nN = N / BM; nwg = nM * nN; G = G_; c = c_; }
    __host__ __device__ bool next(int i, Unit& u) const {
        const long L = (long)i * G + c; if (L >= nwg) return false;
        int wgid = (int)L; { const int q = nwg / NXCD, r = nwg % NXCD, xcd = wgid % NXCD, off = wgid / NXCD; wgid = (xcd < r ? xcd * (q + 1) : r * (q + 1) + (xcd - r) * q) + off; }
        const int nig = WGM * nN, gid = wgid / nig, fm = gid * WGM, gsz = (nM - fm) < WGM ? (nM - fm) : WGM;
        u.pm = fm + ((wgid % nig) % gsz); u.pn = (wgid % nig) / gsz; return true;
    }
};

template <class Epi, class Sched>
__device__ __forceinline__ void gemm_phase(LAS unsigned char* lds, const Gemm g, const Sched& S, const Epi& E, int wid) {
    const int lane = lane_id_v(), tid = wid * 64 + lane;
    const int wr = wid >> 2, wc = wid & 3, fr = lane & 15, fq = lane >> 4;
    const int K = g.K, nt = K / BK;
    unsigned voffA[2];
#pragma unroll
    for (int i = 0; i < 2; ++i) { int R, C; stage_rc(tid * 16 + i * 8192, R, C); voffA[i] = (unsigned)(R * K + C) * 2u; }
    const size_t kstep = (size_t)(BK * 2);
    const size_t hstep = (size_t)HALF * K * 2;
    const size_t tstep = 2 * hstep;
    const unsigned ldsw = (unsigned)wid * 1024u;
    const int aoff = lds_byte(wr * 64 + fr, fq * 8), boff = lds_byte(wc * 32 + fr, fq * 8);
#define PG8_SA(b, h) (((b) * 2 + (h)) * HTB)
#define PG8_SB(b, h) ((4 + (b) * 2 + (h)) * HTB)
#define PG8_STAGE(bufoff, gbase) do { _Pragma("unroll") for (int _i = 0; _i < 2; ++_i) \
        __builtin_amdgcn_global_load_lds((const unsigned*)((const char*)(gbase) + voffA[_i]), (LAS unsigned*)(lds + (bufoff) + ldsw + _i * 8192), 16, 0, 0); } while (0)
#define PG8_LDA(dst, b, h) do { _Pragma("unroll") for (int m = 0; m < 4; ++m) _Pragma("unroll") for (int k = 0; k < 2; ++k) dst[m][k] = *(const LAS bf16x8*)(lds + PG8_SA(b, h) + aoff + m * 2048 + k * 1024); } while (0)
#define PG8_LDB(dst, b, h) do { _Pragma("unroll") for (int n = 0; n < 2; ++n) _Pragma("unroll") for (int k = 0; k < 2; ++k) dst[n][k] = *(const LAS bf16x8*)(lds + PG8_SB(b, h) + boff + n * 2048 + k * 1024); } while (0)
#define PG8_MMA(ai, bj, At, Bt) do { __builtin_amdgcn_s_setprio(1); _Pragma("unroll") for (int m = 0; m < 4; ++m) _Pragma("unroll") for (int n = 0; n < 2; ++n) _Pragma("unroll") for (int k = 0; k < 2; ++k) \
        acc[ai][bj][m][n] = __builtin_amdgcn_mfma_f32_16x16x32_bf16(Bt[n][k], At[m][k], acc[ai][bj][m][n], 0, 0, 0); __builtin_amdgcn_s_setprio(0); } while (0)
#define PG8_WAIT_V(n) asm volatile("s_waitcnt vmcnt(" #n ")" ::: "memory")
#define PG8_WAIT_L(n) asm volatile("s_waitcnt lgkmcnt(" #n ")" ::: "memory")
#define PG8_BAR __builtin_amdgcn_s_barrier()
#define PG8_SCHED __builtin_amdgcn_sched_barrier(0)
    Unit cur, nxt; int ui = 0;
    if (!S.next(0, cur)) return;
    f32x4 acc[2][2][4][2];
#pragma unroll
    for (int a = 0; a < 2; ++a)
#pragma unroll
        for (int b = 0; b < 2; ++b)
#pragma unroll
            for (int m = 0; m < 4; ++m)
#pragma unroll
                for (int n = 0; n < 2; ++n) acc[a][b][m][n] = (f32x4){0.f, 0.f, 0.f, 0.f};
    bf16x8 At[4][2], B0[2][2], B1[2][2];
    const char* cA = (const char*)g.A + (size_t)cur.pm * tstep; const char* cB = (const char*)g.Bt + (size_t)cur.pn * tstep;
    PG8_STAGE(PG8_SB(0, 0), cB); PG8_STAGE(PG8_SB(0, 1), cB + hstep); PG8_STAGE(PG8_SA(0, 0), cA); PG8_STAGE(PG8_SA(0, 1), cA + hstep);
    if (wr == 1) PG8_BAR;
    PG8_WAIT_V(2); PG8_BAR;
    PG8_STAGE(PG8_SB(1, 0), cB + kstep); PG8_STAGE(PG8_SA(1, 0), cA + kstep); PG8_STAGE(PG8_SB(1, 1), cB + hstep + kstep);
    PG8_WAIT_V(6); PG8_BAR;
    for (;;) {
        const bool has_next = S.next(ui + 1, nxt);
        const char* nA = has_next ? (const char*)g.A + (size_t)nxt.pm * tstep : cA; const char* nB = has_next ? (const char*)g.Bt + (size_t)nxt.pn * tstep : cB;
        for (int t = 0; t < nt; t += 2) {
            const bool last = (t == nt - 2);
            const char* a1 = cA + (size_t)(t + 1) * kstep;
            const char* a2 = last ? nA : cA + (size_t)(t + 2) * kstep; const char* b2 = last ? nB : cB + (size_t)(t + 2) * kstep;
            const char* a3 = a2 + kstep; const char* b3 = b2 + kstep;
            PG8_LDB(B0, 0, 0); PG8_LDB(B1, 0, 1); PG8_SCHED; PG8_LDA(At, 0, 0); PG8_STAGE(PG8_SA(1, 1), a1 + hstep);
            PG8_WAIT_V(8); PG8_WAIT_L(0); PG8_BAR; PG8_MMA(0, 0, At, B0); PG8_MMA(0, 1, At, B1); PG8_BAR; PG8_SCHED;
            PG8_LDA(At, 0, 1); PG8_STAGE(PG8_SB(0, 0), b2); PG8_STAGE(PG8_SB(0, 1), b2 + hstep); PG8_STAGE(PG8_SA(0, 0), a2);
            PG8_WAIT_V(8); PG8_WAIT_L(0); PG8_BAR; PG8_MMA(1, 0, At, B0); PG8_MMA(1, 1, At, B1); PG8_BAR; PG8_SCHED;
            PG8_LDB(B0, 1, 0); PG8_LDB(B1, 1, 1); PG8_SCHED; PG8_LDA(At, 1, 0); PG8_STAGE(PG8_SA(0, 1), a2 + hstep);
            PG8_WAIT_V(8); PG8_WAIT_L(0); PG8_BAR; PG8_MMA(0, 0, At, B0); PG8_MMA(0, 1, At, B1); PG8_BAR; PG8_SCHED;
            PG8_LDA(At, 1, 1); PG8_STAGE(PG8_SB(1, 0), b3); PG8_STAGE(PG8_SB(1, 1), b3 + hstep); PG8_STAGE(PG8_SA(1, 0), a3);
            PG8_WAIT_V(8); PG8_WAIT_L(0); PG8_BAR; PG8_MMA(1, 0, At, B0); PG8_MMA(1, 1, At, B1); PG8_BAR; PG8_SCHED;
        }
        if (wr == 0) PG8_BAR;
        E(acc, cur, wr, wc, fr, fq);
        if (!has_next) break;
#pragma unroll
        for (int a = 0; a < 2; ++a)
#pragma unroll
            for (int b = 0; b < 2; ++b)
#pragma unroll
                for (int m = 0; m < 4; ++m)
#pragma unroll
                    for (int n = 0; n < 2; ++n) acc[a][b][m][n] = (f32x4){0.f, 0.f, 0.f, 0.f};
        cur = nxt; cA = nA; cB = nB; ++ui;
        if (wr == 1) PG8_BAR;
    }
    PG8_WAIT_V(0);
    PG8_BAR;
#undef PG8_SA
#undef PG8_SB
#undef PG8_STAGE
#undef PG8_LDA
#undef PG8_LDB
#undef PG8_MMA
#undef PG8_WAIT_V
#undef PG8_WAIT_L
#undef PG8_BAR
#undef PG8_SCHED
}

template <class F> struct EpiWrap {
    F f;
    __device__ __forceinline__ void operator()(const f32x4 (&acc)[2][2][4][2], const Unit& u, int wr, int wc, int fr, int fq) const {
#pragma unroll
        for (int bj = 0; bj < 2; ++bj)
#pragma unroll
            for (int n = 0; n < 2; ++n) {
                const int col = u.pn * BM + bj * HALF + wc * 32 + n * 16 + fq * 4;
#pragma unroll
                for (int ai = 0; ai < 2; ++ai)
#pragma unroll
                    for (int m = 0; m < 4; ++m) f(u.pm * BM + ai * HALF + wr * 64 + m * 16 + fr, col, acc[ai][bj][m][n], fq);
            }
    }
};
}

struct FMkv {
    float* out; bf16_t* mkv; int l;
    __device__ __forceinline__ void operator()(int row, int col, f32x4 v, int) const {
        const int c = col;
        *(f32x4*)(out + O5 + ((size_t)l * 2048 + row) * 2048 + c) = v;
        *(u32x2*)(mkv + ((size_t)l * 2048 + row) * 2048 + c) = pk4(v);
    }
};
struct FProj {
    bf16_t *Qb, *Kb, *Vb, *Ub, *Gb; const float* rope; float* out; int l; float* gst;
    __device__ __forceinline__ void kvout(int row, int c, int kv, f32x4 v) const {
        const int head = c >> 6, g = head >> 2, hs = head & 3, dd = c & 63;
        if (row < MP) {
            const int b = row >> 11, t = row & 2047;
            const int win = g == 0 ? 128 : (g == 1 ? 512 : 2048);
            const int tw = t - (2048 - win);
            if (tw >= 0) {
                const size_t base = g == 0 ? O2 : (g == 1 ? O3 : O4);
                *(f32x4*)(out + base + ((((size_t)l * NB + b) * win + tw) * 2 + kv) * 256 + hs * 64 + dd) = v;
            }
        } else if (row < MR) {
            const int r = row - MP;
            const size_t base = g == 0 ? O6 : (g == 1 ? O7 : O8);
            *(f32x4*)(out + base + (((size_t)l * MS + r) * 2 + kv) * 256 + hs * 64 + dd) = v;
        }
    }
    __device__ __forceinline__ void operator()(int row, int col, f32x4 v, int fq, float& s1, float& s2) const {
        if (col < 1536) {
            const bool isk = col >= 768; const int c = isk ? col - 768 : col;
            if ((c & 48) == 0) {
                const int pos = row < MP ? (row & 2047) : 2048 + ((row - MP) & 3);
                const float* rt = rope + pos * 16 + (fq & 1) * 4;
                const f32x4 cs = *(const f32x4*)rt, sn = *(const f32x4*)(rt + 8);
                f32x4 o; o.x = __shfl_xor(v.x, 32); o.y = __shfl_xor(v.y, 32); o.z = __shfl_xor(v.z, 32); o.w = __shfl_xor(v.w, 32);
                if (fq < 2) v = v * cs - o * sn; else v = v * cs + o * sn;
            }
            if (!isk) { *(u32x2*)(Qb + (size_t)row * ATT + c) = pk4(v * QSCALE); }
            else { *(u32x2*)(Kb + (size_t)row * ATT + c) = pk4(v); kvout(row, c, 0, v); }
        } else if (col < 2304) {
            const int c = col - 1536;
            *(u32x2*)(Vb + (size_t)row * ATT + c) = pk4(v); kvout(row, c, 1, v);
        } else {
            f32x4 gl; gl.x = gelu_tanh(v.x); gl.y = gelu_tanh(v.y); gl.z = gelu_tanh(v.z); gl.w = gelu_tanh(v.w);
            if (col < 2560) *(u32x2*)(Ub + (size_t)row * 256 + (col - 2304)) = pk4(gl);
            else { const u32x2 pg = pk4(gl); *(u32x2*)(Gb + (size_t)row * 256 + (col - 2560)) = pg;
                const float z0 = bflo(pg.x), z1 = bfhi(pg.x), z2 = bflo(pg.y), z3 = bfhi(pg.y);
                s1 += (z0 + z1) + (z2 + z3); s2 += (z0 * z0 + z1 * z1) + (z2 * z2 + z3 * z3); }
        }
    }
    __device__ __forceinline__ void finish(const pg8::Unit& u, int wr, int wc, int fr, int fq, float (&s1)[2][4], float (&s2)[2][4]) const {
        if (u.pn != 10) return;
#pragma unroll
        for (int ai = 0; ai < 2; ++ai)
#pragma unroll
            for (int m = 0; m < 4; ++m) {
                float a = s1[ai][m], b = s2[ai][m];
                a += __shfl_xor(a, 16); b += __shfl_xor(b, 16); a += __shfl_xor(a, 32); b += __shfl_xor(b, 32);
                if (fq == 0) { float* p = gst + (size_t)(u.pm * 256 + ai * 128 + wr * 64 + m * 16 + fr) * 8 + wc * 2; p[0] = a; p[1] = b; }
            }
    }
};
__device__ __forceinline__ void stats_main(const float* stm, int row, int fq, float& mu, float& rs) {
    const f32x4* p = (const f32x4*)(stm + (size_t)row * 32 + fq * 8);
    const f32x4 a = p[0], b = p[1];
    float s1 = (a.x + a.z) + (b.x + b.z), s2 = (a.y + a.w) + (b.y + b.w);
    s1 += __shfl_xor(s1, 16); s2 += __shfl_xor(s2, 16); s1 += __shfl_xor(s1, 32); s2 += __shfl_xor(s2, 32);
    mu = s1 * (1.f / DM); rs = 1.f / sqrtf(fmaxf(s2 * (1.f / DM) - mu * mu, 0.f) + LN_EPS);
}
__device__ __forceinline__ void stats_sk(const float* sts, int row, int fq, float& mu, float& rs) {
    const f32x4* p = (const f32x4*)(sts + (size_t)(row - MP) * 128 + fq * 32);
    float s1 = 0.f, s2 = 0.f;
#pragma unroll
    for (int i = 0; i < 8; ++i) { const f32x4 a = p[i]; s1 += a.x + a.z; s2 += a.y + a.w; }
    s1 += __shfl_xor(s1, 16); s2 += __shfl_xor(s2, 16); s1 += __shfl_xor(s1, 32); s2 += __shfl_xor(s2, 32);
    mu = s1 * (1.f / DM); rs = 1.f / sqrtf(fmaxf(s2 * (1.f / DM) - mu * mu, 0.f) + LN_EPS);
}
template <class F> struct EpiFold {
    F f; bool fold; const float* stm; const float* sts; const float* c1; const float* c2;
    __device__ __forceinline__ void operator()(const f32x4 (&acc)[2][2][4][2], const pg8::Unit& u, int wr, int wc, int fr, int fq) const {
        float mu[2][4], rs[2][4], ps1[2][4], ps2[2][4];
#pragma unroll
        for (int ai = 0; ai < 2; ++ai)
#pragma unroll
            for (int m = 0; m < 4; ++m) { ps1[ai][m] = 0.f; ps2[ai][m] = 0.f; mu[ai][m] = 0.f; rs[ai][m] = 1.f; if (fold) stats_main(stm, u.pm * 256 + ai * 128 + wr * 64 + m * 16 + fr, fq, mu[ai][m], rs[ai][m]); }
#pragma unroll
        for (int bj = 0; bj < 2; ++bj)
#pragma unroll
            for (int n = 0; n < 2; ++n) {
                const int col = u.pn * 256 + bj * 128 + wc * 32 + n * 16 + fq * 4;
                f32x4 c1v = (f32x4){0.f, 0.f, 0.f, 0.f}, c2v = c1v;
                if (fold) { c1v = *(const f32x4*)(c1 + col); c2v = *(const f32x4*)(c2 + col); }
#pragma unroll
                for (int ai = 0; ai < 2; ++ai)
#pragma unroll
                    for (int m = 0; m < 4; ++m) {
                        f32x4 v = acc[ai][bj][m][n];
                        if (fold) v = (v - c1v * mu[ai][m]) * rs[ai][m] + c2v;
                        f(u.pm * 256 + ai * 128 + wr * 64 + m * 16 + fr, col, v, fq, ps1[ai][m], ps2[ai][m]);
                    }
            }
        f.finish(u, wr, wc, fr, fq, ps1, ps2);
    }
    __device__ __forceinline__ void sk(int row, int col, f32x4 v, int fq) const {
        if (fold) { float mu, rs; stats_sk(sts, row, fq, mu, rs); const f32x4 c1v = *(const f32x4*)(c1 + col), c2v = *(const f32x4*)(c2 + col); v = (v - c1v * mu) * rs + c2v; }
        float d1 = 0.f, d2 = 0.f; f(row, col, v, fq, d1, d2);
    }
};
struct EpiRes {
    const bf16_t* src; bf16_t* dst; bool ln; const float* stm_p; const float* sts_p; const float* g; const float* b; float* stm_n; float* sts_n;
    __device__ __forceinline__ void operator()(const f32x4 (&acc)[2][2][4][2], const pg8::Unit& u, int wr, int wc, int fr, int fq) const {
#pragma unroll
        for (int ai = 0; ai < 2; ++ai)
#pragma unroll
            for (int m = 0; m < 4; ++m) {
                const int row = u.pm * 256 + ai * 128 + wr * 64 + m * 16 + fr;
                float mu = 0.f, rs = 1.f; if (ln) stats_main(stm_p, row, fq, mu, rs);
                float s1 = 0.f, s2 = 0.f;
#pragma unroll
                for (int bj = 0; bj < 2; ++bj)
#pragma unroll
                    for (int n = 0; n < 2; ++n) {
                        const int col = u.pn * 256 + bj * 128 + wc * 32 + n * 16 + fq * 4;
                        const u32x2 raw = *(const u32x2*)(src + (size_t)row * DM + col);
                        f32x4 x = (f32x4){bflo(raw.x), bfhi(raw.x), bflo(raw.y), bfhi(raw.y)};
                        if (ln) x = (x - mu) * rs * *(const f32x4*)(g + col) + *(const f32x4*)(b + col);
                        const u32x2 pz = pk4(x * ALPHA + acc[ai][bj][m][n]);
                        *(u32x2*)(dst + (size_t)row * DM + col) = pz;
                        const float z0 = bflo(pz.x), z1 = bfhi(pz.x), z2 = bflo(pz.y), z3 = bfhi(pz.y);
                        s1 += (z0 + z1) + (z2 + z3); s2 += (z0 * z0 + z1 * z1) + (z2 * z2 + z3 * z3);
                    }
                s1 += __shfl_xor(s1, 16); s2 += __shfl_xor(s2, 16); s1 += __shfl_xor(s1, 32); s2 += __shfl_xor(s2, 32);
                if (fq == 0) { float* p = stm_n + (size_t)row * 32 + (u.pn * 4 + wc) * 2; p[0] = s1; p[1] = s2; }
            }
    }
    __device__ __forceinline__ void sk(int row, int col, f32x4 v, int fq) const {
        float mu = 0.f, rs = 1.f; if (ln) stats_sk(sts_p, row, fq, mu, rs);
        const u32x2 raw = *(const u32x2*)(src + (size_t)row * DM + col);
        f32x4 x = (f32x4){bflo(raw.x), bfhi(raw.x), bflo(raw.y), bfhi(raw.y)};
        if (ln) x = (x - mu) * rs * *(const f32x4*)(g + col) + *(const f32x4*)(b + col);
        const u32x2 pz = pk4(x * ALPHA + v);
        *(u32x2*)(dst + (size_t)row * DM + col) = pz;
        const float z0 = bflo(pz.x), z1 = bfhi(pz.x), z2 = bflo(pz.y), z3 = bfhi(pz.y);
        float s1 = (z0 + z1) + (z2 + z3), s2 = (z0 * z0 + z1 * z1) + (z2 * z2 + z3 * z3);
        s1 += __shfl_xor(s1, 16); s2 += __shfl_xor(s2, 16); s1 += __shfl_xor(s1, 32); s2 += __shfl_xor(s2, 32);
        if (fq == 0) { float* p = sts_n + (size_t)(row - MP) * 128 + (col >> 4) * 2; p[0] = s1; p[1] = s2; }
    }
};
struct FScaleBf {
    bf16_t* O; int ldc; float s;
    __device__ __forceinline__ void operator()(int row, int col, f32x4 v, int, float&, float&) const { *(u32x2*)(O + (size_t)row * ldc + col) = pk4(v * s); }
    __device__ __forceinline__ void finish(const pg8::Unit&, int, int, int, int, float (&)[2][4], float (&)[2][4]) const {}
};
struct FRelu2 {
    bf16_t* O;
    __device__ __forceinline__ void finish(const pg8::Unit&, int, int, int, int, float (&)[2][4], float (&)[2][4]) const {}
    __device__ __forceinline__ void operator()(int row, int col, f32x4 v, int, float&, float&) const {
        f32x4 r; r.x = fmaxf(v.x, 0.f); r.y = fmaxf(v.y, 0.f); r.z = fmaxf(v.z, 0.f); r.w = fmaxf(v.w, 0.f);
        *(u32x2*)(O + (size_t)row * FF + col) = pk4(r * r);
    }
};

struct TDesc { const float* W; bf16_t* WT; const float* gsc; const float* bsc; float* cvp; int K, N, item; };
__device__ __forceinline__ void p0_load(const TDesc& d, float (&wv)[32], int lane) {
    const int nblk = d.N / 32, kb = d.item / nblk, nb = d.item % nblk, k0 = 64 * kb, n0 = 32 * nb;
#pragma unroll
    for (int i = 0; i < 32; ++i) wv[i] = d.W[(size_t)(k0 + 2 * i + (lane >> 5)) * d.N + n0 + (lane & 31)];
}
__device__ __forceinline__ void p0_finish(const TDesc& d, float (&wv)[32], LAS float* scr, int lane) {
    const int nblk = d.N / 32, kb = d.item / nblk, nb = d.item % nblk, k0 = 64 * kb, n0 = 32 * nb, K = d.K;
    if (d.gsc) {
        float c1 = 0.f, c2 = 0.f;
#pragma unroll
        for (int i = 0; i < 32; ++i) { const int k = k0 + 2 * i + (lane >> 5); c2 += d.bsc[k] * wv[i]; wv[i] *= d.gsc[k]; c1 += bf2f((unsigned short)f2bf(wv[i])); }
        c1 += __shfl_xor(c1, 32); c2 += __shfl_xor(c2, 32);
        if (lane < 32) { float* p = d.cvp + (size_t)kb * 2 * 4096 + n0 + lane; p[0] = c1; p[4096] = c2; }
    }
#pragma unroll
    for (int i = 0; i < 32; ++i) scr[(2 * i + (lane >> 5)) * 33 + (lane & 31)] = wv[i];
    LDS_WAIT(); asm volatile("" ::: "memory");
    const int c = lane & 7;
#pragma unroll
    for (int j = 0; j < 4; ++j) { const int n = (lane >> 3) + 8 * j; const LAS float* sp = scr + (8 * c) * 33 + n;
        u32x4 o; o.x = pk2(sp[0 * 33], sp[1 * 33]); o.y = pk2(sp[2 * 33], sp[3 * 33]); o.z = pk2(sp[4 * 33], sp[5 * 33]); o.w = pk2(sp[6 * 33], sp[7 * 33]);
        *(u32x4*)(d.WT + (size_t)(n0 + n) * K + k0 + 8 * c) = o; }
    LDS_WAIT(); asm volatile("" ::: "memory");
}

struct Args { const float* in[24]; float* out; unsigned char* ws; int ph_lo, ph_hi; };

__device__ __forceinline__ void final_ln(const bf16_t* ZB, const float* gam, const float* bet, float* yout, int gw, int NGW, int lane) {
    f32x4 gv[4], bv[4];
#pragma unroll
    for (int j = 0; j < 4; ++j) { gv[j] = *(const f32x4*)(gam + 4 * lane + 256 * j); bv[j] = *(const f32x4*)(bet + 4 * lane + 256 * j); }
    for (int row = gw; row < MR; row += NGW) {
        const u32x2* zr = (const u32x2*)(ZB + (size_t)row * DM) + lane;
        f32x4 v[4]; float s = 0.f;
#pragma unroll
        for (int j = 0; j < 4; ++j) { const u32x2 raw = zr[64 * j]; v[j] = (f32x4){bflo(raw.x), bfhi(raw.x), bflo(raw.y), bfhi(raw.y)}; s += (v[j].x + v[j].y) + (v[j].z + v[j].w); }
        const float mean = wave_sum(s) * (1.f / DM); float s2 = 0.f;
#pragma unroll
        for (int j = 0; j < 4; ++j) { v[j] = v[j] - mean; s2 += (v[j].x * v[j].x + v[j].y * v[j].y) + (v[j].z * v[j].z + v[j].w * v[j].w); }
        const float rstd = 1.f / sqrtf(wave_sum(s2) * (1.f / DM) + LN_EPS);
        f32x4* o = (f32x4*)(yout + (size_t)row * DM) + lane;
#pragma unroll
        for (int j = 0; j < 4; ++j) o[64 * j] = v[j] * rstd * gv[j] + bv[j];
    }
}

template <bool SAMPLE>
__device__ __forceinline__ void attn_tile(const bf16_t* Qb, const bf16_t* Kb, const bf16_t* Vb, const float* c0, const float* c1, const float* c2, int l,
                                          LAS unsigned char* orow, LAS float* lsep, LAS unsigned char* vl, int b, int h, int rq, int sb, int lane) {
    const int fr = lane & 15, fq = lane >> 4;
    int s0 = 0, r = 0, qi = 0, kt0 = 0;
    const int g = h >> 2, hs = h & 3, dsh = 2 * g;
    const int npre = g == 0 ? 128 : (g == 1 ? 512 : 2048);
    size_t qrow;
    if (SAMPLE) { qi = rq; qrow = (size_t)MP + b * 4 + qi; }
    else { r = rq; s0 = sb * 16; kt0 = sb >= 8 ? 0 : 8 - sb; qrow = (size_t)b * SEQ + (((s0 + fr) << dsh) + r); }
    const float* cbase = SAMPLE ? (g == 0 ? c0 : (g == 1 ? c1 : c2)) + (size_t)(l * DECB + b) * npre * 512 : nullptr;
    const bf16_t* qp = Qb + qrow * ATT + h * 64 + fq * 8;
    const bf16x8 q0 = *(const bf16x8*)qp, q1 = *(const bf16x8*)(qp + 32);
    u32x4 vr[5][4];
#pragma unroll
    for (int kk = 0; kk < 5; ++kk) {
#pragma unroll
        for (int it = 0; it < 4; ++it) vr[kk][it] = (u32x4){0u, 0u, 0u, 0u};
        if (2 * kk + 1 >= kt0) {
#pragma unroll
            for (int it = 0; it < 4; ++it) {
                const int rl = (lane >> 3) + 8 * it, ch = lane & 7;
                u32x4 w;
                if (SAMPLE) {
                    int j = 32 * kk + rl; j = j > 128 ? 128 : j;
                    const int rr = npre + qi - (j << dsh);
                    if (rr >= npre) w = *(const u32x4*)(Vb + ((size_t)MP + b * 4 + (rr - npre)) * ATT + h * 64 + ch * 8);
                    else { const float* vp = cbase + (size_t)rr * 512 + 256 + hs * 64 + ch * 8; const f32x4 a0 = __builtin_nontemporal_load((const f32x4*)vp), a1 = __builtin_nontemporal_load((const f32x4*)(vp + 4));
                        w.x = pk2(a0.x, a0.y); w.y = pk2(a0.z, a0.w); w.z = pk2(a1.x, a1.y); w.w = pk2(a1.z, a1.w); }
                } else {
                    int sk = s0 - 128 + 32 * kk + rl; sk = sk < 0 ? 0 : sk; sk = sk > s0 + 15 ? s0 + 15 : sk;
                    w = *(const u32x4*)(Vb + ((size_t)b * SEQ + ((sk << dsh) + r)) * ATT + h * 64 + ch * 8);
                }
                vr[kk][it] = w;
            }
        }
    }
    f32x4 S[9];
#pragma unroll
    for (int kt = 0; kt < 9; ++kt) {
        S[kt] = (f32x4){-1e30f, -1e30f, -1e30f, -1e30f};
        if (kt >= kt0) {
            bf16x8 k0, k1;
            if (SAMPLE) {
                int j = 16 * kt + fr; j = j > 128 ? 128 : j;
                const int rr = npre + qi - (j << dsh);
                if (rr >= npre) { const bf16_t* kp = Kb + ((size_t)MP + b * 4 + (rr - npre)) * ATT + h * 64 + fq * 8; k0 = *(const bf16x8*)kp; k1 = *(const bf16x8*)(kp + 32); }
                else { const float* kp = cbase + (size_t)rr * 512 + hs * 64 + fq * 8;
                    const f32x4 a0 = __builtin_nontemporal_load((const f32x4*)kp), a1 = __builtin_nontemporal_load((const f32x4*)(kp + 4)), a2 = __builtin_nontemporal_load((const f32x4*)(kp + 32)), a3 = __builtin_nontemporal_load((const f32x4*)(kp + 36));
                    u32x4 w0, w1; w0.x = pk2(a0.x, a0.y); w0.y = pk2(a0.z, a0.w); w0.z = pk2(a1.x, a1.y); w0.w = pk2(a1.z, a1.w);
                    w1.x = pk2(a2.x, a2.y); w1.y = pk2(a2.z, a2.w); w1.z = pk2(a3.x, a3.y); w1.w = pk2(a3.z, a3.w);
                    k0 = __builtin_bit_cast(bf16x8, w0); k1 = __builtin_bit_cast(bf16x8, w1); }
            } else {
                const int sk = s0 - 128 + 16 * kt + fr;
                const bf16_t* kp = Kb + ((size_t)b * SEQ + ((sk << dsh) + r)) * ATT + h * 64 + fq * 8;
                k0 = *(const bf16x8*)kp; k1 = *(const bf16x8*)(kp + 32);
            }
            f32x4 a = (f32x4){0.f, 0.f, 0.f, 0.f};
            a = __builtin_amdgcn_mfma_f32_16x16x32_bf16(k0, q0, a, 0, 0, 0);
            a = __builtin_amdgcn_mfma_f32_16x16x32_bf16(k1, q1, a, 0, 0, 0);
            S[kt] = a;
        }
    }
    if (SAMPLE) {
#pragma unroll
        for (int j = 0; j < 4; ++j) if (4 * fq + j > 0) S[8][j] = -1e30f;
    } else {
#pragma unroll
        for (int j = 0; j < 4; ++j) { if (4 * fq + j < fr) S[0][j] = -1e30f; if (4 * fq + j > fr) S[8][j] = -1e30f; }
    }
    float m = -1e30f;
#pragma unroll
    for (int kt = 0; kt < 9; ++kt) m = fmaxf(m, fmaxf(fmaxf(S[kt].x, S[kt].y), fmaxf(S[kt].z, S[kt].w)));
    m = fmaxf(m, __shfl_xor(m, 16)); m = fmaxf(m, __shfl_xor(m, 32));
    float den = 0.f;
#pragma unroll
    for (int kt = 0; kt < 9; ++kt) { S[kt].x = __builtin_amdgcn_exp2f(S[kt].x - m); S[kt].y = __builtin_amdgcn_exp2f(S[kt].y - m); S[kt].z = __builtin_amdgcn_exp2f(S[kt].z - m); S[kt].w = __builtin_amdgcn_exp2f(S[kt].w - m); den += (S[kt].x + S[kt].y) + (S[kt].z + S[kt].w); }
    den += __shfl_xor(den, 16); den += __shfl_xor(den, 32);
    f32x4 O[4];
#pragma unroll
    for (int n = 0; n < 4; ++n) O[n] = (f32x4){0.f, 0.f, 0.f, 0.f};
    const LAS unsigned char* trp = vl + (4 * fq + (fr >> 2)) * 160 + (lane & 3) * 8;
#pragma unroll
    for (int kk = 0; kk < 5; ++kk) {
        if (2 * kk + 1 >= kt0) {
#pragma unroll
            for (int it = 0; it < 4; ++it) *(LAS u32x4*)(vl + ((lane >> 3) + 8 * it) * 160 + (lane & 7) * 16) = vr[kk][it];
            asm volatile("" ::: "memory");
            u32x4 pw; pw.x = pk2(S[2 * kk].x, S[2 * kk].y); pw.y = pk2(S[2 * kk].z, S[2 * kk].w);
            if (kk < 4) { pw.z = pk2(S[(2 * kk + 1) % 9].x, S[(2 * kk + 1) % 9].y); pw.w = pk2(S[(2 * kk + 1) % 9].z, S[(2 * kk + 1) % 9].w); } else { pw.z = 0u; pw.w = 0u; }
            const bf16x8 pb = __builtin_bit_cast(bf16x8, pw);
#pragma unroll
            for (int n = 0; n < 4; ++n) {
                const s16x4 lo = vtr(trp + n * 32), hi = vtr(trp + 16 * 160 + n * 32);
                bf16x8 va; va[0] = lo[0]; va[1] = lo[1]; va[2] = lo[2]; va[3] = lo[3]; va[4] = hi[0]; va[5] = hi[1]; va[6] = hi[2]; va[7] = hi[3];
                O[n] = __builtin_amdgcn_mfma_f32_16x16x32_bf16(va, pb, O[n], 0, 0, 0);
            }
            asm volatile("" ::: "memory");
        }
    }
    const float inv = __builtin_amdgcn_rcpf(den);
    if (!SAMPLE || fr == 0) {
#pragma unroll
        for (int n = 0; n < 4; ++n) *(LAS u32x2*)(orow + 32 * n + 8 * fq) = pk4(O[n] * inv);
        if (fq == 0) *lsep = m * LN2 + __logf(den);
    }
}

#define WG_BAR() do { asm volatile("s_waitcnt lgkmcnt(0)" ::: "memory"); __builtin_amdgcn_s_barrier(); asm volatile("" ::: "memory"); } while (0)
constexpr int XA_BUF = 128 * 544;
template <bool SAMPLE>
__device__ __forceinline__ void xa_load(u32x4 (&r)[8], const bf16_t* MKVl, const float* cmem, int b, int h, int kv, int half, int tid) {
#pragma unroll
    for (int ps = 0; ps < 8; ++ps) {
        const int row = half * 128 + ps * 16 + (tid >> 5), ch = tid & 31;
        if (SAMPLE) { const float* p = cmem + ((size_t)(b * 256 + row) * 2 + kv) * 1024 + h * 256 + ch * 8; const f32x4 a0 = __builtin_nontemporal_load((const f32x4*)p), a1 = __builtin_nontemporal_load((const f32x4*)(p + 4));
            r[ps].x = pk2(a0.x, a0.y); r[ps].y = pk2(a0.z, a0.w); r[ps].z = pk2(a1.x, a1.y); r[ps].w = pk2(a1.z, a1.w); }
        else r[ps] = *(const u32x4*)(MKVl + (size_t)(b * 256 + row) * 2048 + kv * 1024 + h * 256 + ch * 8);
    }
}
__device__ __forceinline__ void xa_load_any(u32x4 (&r)[8], const bf16_t* MKVl, const float* cmem, int u, int tid) {
    if (u < DECB * 4) xa_load<true>(r, MKVl, cmem, u >> 2, u & 3, 0, 0, tid);
    else { const int v = u - DECB * 4; xa_load<false>(r, MKVl, cmem, v >> 6, (v >> 4) & 3, 0, 0, tid); }
}
__device__ __forceinline__ void xa_store(const u32x4 (&r)[8], LAS unsigned char* buf, int stride, int tid) {
#pragma unroll
    for (int ps = 0; ps < 8; ++ps) *(LAS u32x4*)(buf + (ps * 16 + (tid >> 5)) * stride + (tid & 31) * 16) = r[ps];
}
__device__ __forceinline__ void xa_s_half(f32x4* S8, const bf16x8 (&qf)[8], const LAS unsigned char* buf, int fr, int fq) {
    bf16x8 kf[2][8];
    const LAS unsigned char* kbase = buf + fr * 528 + fq * 16;
#pragma unroll
    for (int ks = 0; ks < 8; ++ks) kf[0][ks] = *(const LAS bf16x8*)(kbase + ks * 64);
#pragma unroll
    for (int kt = 0; kt < 8; ++kt) {
        if (kt + 1 < 8) {
#pragma unroll
            for (int ks = 0; ks < 8; ++ks) kf[(kt + 1) & 1][ks] = *(const LAS bf16x8*)(kbase + (kt + 1) * 16 * 528 + ks * 64);
        }
        f32x4 a = (f32x4){0.f, 0.f, 0.f, 0.f};
#pragma unroll
        for (int ks = 0; ks < 8; ++ks) a = __builtin_amdgcn_mfma_f32_16x16x32_bf16(kf[kt & 1][ks], qf[ks], a, 0, 0, 0);
        S8[kt] = a;
        __builtin_amdgcn_sched_barrier(0);
    }
}
template <bool SAMPLE>
__device__ __forceinline__ void xattn_unit(const bf16_t* XQ, const bf16_t* MKVl, const float* cmem, bf16_t* XO, LAS unsigned char* lds, int u, int next, u32x4 (&kpre)[8], int wave) {
    const int lane = lane_id_v(), tid = wave * 64 + lane, fr = lane & 15, fq = lane >> 4;
    int b, h; size_t qrow;
    if (SAMPLE) { b = u >> 2; h = u & 3; qrow = (size_t)MP + b * 4 + (fr & 3); }
    else { const int v = u - DECB * 4; b = v >> 6; h = (v >> 4) & 3; qrow = (size_t)b * SEQ + (v & 15) * 128 + wave * 16 + fr; }
    LAS unsigned char* bufA = lds; LAS unsigned char* bufB = lds + XA_BUF;
    bf16x8 qf[8];
    { const bf16_t* qp = XQ + qrow * DM + h * 256 + fq * 8;
#pragma unroll
      for (int ks = 0; ks < 8; ++ks) qf[ks] = *(const bf16x8*)(qp + 32 * ks); }
    u32x4 r[8];
    xa_load<SAMPLE>(kpre, MKVl, cmem, b, h, 0, 0, tid);
    xa_load<SAMPLE>(r, MKVl, cmem, b, h, 0, 1, tid);
    WG_BAR();
    xa_store(kpre, bufA, 528, tid);
    xa_load<SAMPLE>(kpre, MKVl, cmem, b, h, 1, 0, tid);
    WG_BAR();
    f32x4 S[16];
    xa_s_half(S, qf, bufA, fr, fq);
    xa_store(r, bufB, 528, tid);
    xa_load<SAMPLE>(r, MKVl, cmem, b, h, 1, 1, tid);
    WG_BAR();
    xa_s_half(S + 8, qf, bufB, fr, fq);
    float m = -1e30f;
#pragma unroll
    for (int kt = 0; kt < 16; ++kt) m = fmaxf(m, fmaxf(fmaxf(S[kt].x, S[kt].y), fmaxf(S[kt].z, S[kt].w)));
    m = fmaxf(m, __shfl_xor(m, 16)); m = fmaxf(m, __shfl_xor(m, 32));
    float den = 0.f;
#pragma unroll
    for (int kt = 0; kt < 16; ++kt) { S[kt].x = __builtin_amdgcn_exp2f(S[kt].x - m); S[kt].y = __builtin_amdgcn_exp2f(S[kt].y - m); S[kt].z = __builtin_amdgcn_exp2f(S[kt].z - m); S[kt].w = __builtin_amdgcn_exp2f(S[kt].w - m); den += (S[kt].x + S[kt].y) + (S[kt].z + S[kt].w); }
    den += __shfl_xor(den, 16); den += __shfl_xor(den, 32);
    u32x4 P[8];
#pragma unroll
    for (int kk = 0; kk < 8; ++kk) { P[kk].x = pk2(S[2 * kk].x, S[2 * kk].y); P[kk].y = pk2(S[2 * kk].z, S[2 * kk].w); P[kk].z = pk2(S[2 * kk + 1].x, S[2 * kk + 1].y); P[kk].w = pk2(S[2 * kk + 1].z, S[2 * kk + 1].w); }
    WG_BAR();
    xa_store(kpre, bufA, 544, tid);
    WG_BAR();
    const float inv = 1.f / den;
    constexpr int NO = SAMPLE ? 2 : 16;
    f32x4 O[NO];
#pragma unroll
    for (int n = 0; n < NO; ++n) O[n] = (f32x4){0.f, 0.f, 0.f, 0.f};
    const int trofs = (4 * fq + (fr >> 2)) * 544 + (lane & 3) * 8 + (SAMPLE ? 2 * wave * 32 : 0);
#pragma unroll 1
    for (int hf = 0; hf < 2; ++hf) {
        if (hf == 1) {
            xa_store(r, bufB, 544, tid);
            WG_BAR();
        }
        const LAS unsigned char* trp = (hf ? bufB : bufA) + trofs;
#pragma unroll 1
        for (int kk = 0; kk < 4; ++kk) {
            const int kq = hf * 4 + kk;
            u32x4 pw = P[0];
#pragma unroll
            for (int q = 1; q < 8; ++q) if (kq == q) pw = P[q];
            const bf16x8 pb = __builtin_bit_cast(bf16x8, pw);
#pragma unroll
            for (int n = 0; n < NO; ++n) {
                const s16x4 lo = vtr(trp + kk * 32 * 544 + n * 32), hi = vtr(trp + kk * 32 * 544 + 16 * 544 + n * 32);
                bf16x8 va; va[0] = lo[0]; va[1] = lo[1]; va[2] = lo[2]; va[3] = lo[3]; va[4] = hi[0]; va[5] = hi[1]; va[6] = hi[2]; va[7] = hi[3];
                O[n] = __builtin_amdgcn_mfma_f32_16x16x32_bf16(va, pb, O[n], 0, 0, 0);
            }
        }
    }
    if (SAMPLE) { if (fr < 4) { bf16_t* op = XO + qrow * DM + h * 256 + 32 * wave + 4 * fq; *(u32x2*)op = pk4(O[0] * inv); *(u32x2*)(op + 16) = pk4(O[NO > 1 ? 1 : 0] * inv); } }
    else { bf16_t* op = XO + qrow * DM + h * 256 + 4 * fq;
#pragma unroll
        for (int n = 0; n < NO; ++n) *(u32x2*)(op + 16 * n) = pk4(O[n] * inv); }
}

template <int KSPLIT, class F>
__device__ __forceinline__ void skinny_gemm(const bf16_t* A, const bf16_t* Bt, int N, int K, const F& f, LAS unsigned char* lds, int bx, int G, int wave) {
    const int lane = lane_id_v(), fr = lane & 15, fq = lane >> 4;
    constexpr int MTW = 8 / KSPLIT, RG = 8 / MTW;
    const int ntiles = RG * (N / 16), klen = K / KSPLIT;
    for (int t = bx; t < ntiles; t += G) {
        const int rg = t % RG, n0 = (t / RG) * 16;
        const int mt = rg * MTW + (wave % MTW), kq = wave / MTW;
        const bf16_t* ap = A + (size_t)(MP + 16 * mt + fr) * K + kq * klen + 8 * fq;
        const bf16_t* bp = Bt + (size_t)(n0 + fr) * K + kq * klen + 8 * fq;
        f32x4 acc = (f32x4){0.f, 0.f, 0.f, 0.f};
#pragma unroll 16
        for (int k = 0; k < klen; k += 32) {
            const bf16x8 af = *(const bf16x8*)(ap + k), bf = *(const bf16x8*)(bp + k);
            acc = __builtin_amdgcn_mfma_f32_16x16x32_bf16(bf, af, acc, 0, 0, 0);
        }
        if (KSPLIT > 1) {
            __syncthreads();
            *(LAS f32x4*)(lds + wave * 1024 + lane * 16) = acc;
            __syncthreads();
            if (kq == 0) {
#pragma unroll
                for (int q = 1; q < KSPLIT; ++q) acc = acc + *(const LAS f32x4*)(lds + (wave + q * MTW) * 1024 + lane * 16);
                f.sk(MP + 16 * mt + fr, n0 + 4 * fq, acc, fq);
            }
        } else f.sk(MP + 16 * mt + fr, n0 + 4 * fq, acc, fq);
    }
}

__global__ void __launch_bounds__(NWAVES * 64, 2) mega(Args args) {
    extern __shared__ __attribute__((aligned(16))) unsigned char lds_raw[];
    LAS unsigned char* lds = (LAS unsigned char*)lds_raw;
    const int wave = __builtin_amdgcn_readfirstlane((int)threadIdx.x >> 6);
    const int G = gridDim.x, bx = blockIdx.x;
    const int gw_ = bx * NWAVES + wave, NGW = G * NWAVES;
    unsigned char* ws = args.ws; float* out = args.out;
    float* ROPE = (float*)(ws + WS_ROPE);
    bf16_t* WIN = (bf16_t*)(ws + WS_WIN); bf16_t* WMIX = (bf16_t*)(ws + WS_WMIX); bf16_t* WXQ = (bf16_t*)(ws + WS_WXQ); bf16_t* WXKV = (bf16_t*)(ws + WS_WXKV);
    bf16_t* WXO = (bf16_t*)(ws + WS_WXO); bf16_t* WUP = (bf16_t*)(ws + WS_WUP); bf16_t* WDN = (bf16_t*)(ws + WS_WDN); bf16_t* WSP = (bf16_t*)(ws + WS_WSP);
    bf16_t* MEMB = (bf16_t*)(ws + WS_MEMB); bf16_t* MKV = (bf16_t*)(ws + WS_MKV);
    bf16_t* XB = (bf16_t*)(ws + WS_XB);
    bf16_t* Qb = (bf16_t*)(ws + WS_Q); bf16_t* Kb = (bf16_t*)(ws + WS_K); bf16_t* Vb = (bf16_t*)(ws + WS_V); bf16_t* Ub = (bf16_t*)(ws + WS_U); bf16_t* Gb = (bf16_t*)(ws + WS_G);
    bf16_t* CAT = (bf16_t*)(ws + WS_CAT); float* LSE = (float*)(ws + WS_LSE);
    bf16_t* XQ = (bf16_t*)(ws + WS_XQ); bf16_t* XO = (bf16_t*)(ws + WS_XO); bf16_t* H = (bf16_t*)(ws + WS_H);
    const int lo = args.ph_lo, hi = args.ph_hi;
    int ph = 0;
    cg::grid_group grid = cg::this_grid();
    volatile LAS unsigned* misc = (volatile LAS unsigned*)(lds + LDS_BYTES - 64);
    if (wave == 0) { const int l0 = lane_id_v(); if (l0 < 2) misc[l0] = 0u; }
    __syncthreads();
    XcdBarrier xbar; xbar.bar = (unsigned*)(ws + WS_BAR); xbar.x = 0; xbar.st = misc;
    if (hi - lo > 1) xbar = xcd_barrier_post((unsigned*)(ws + WS_BAR), misc, wave);
    if (lo < 0) grid.sync();
#ifndef PHMASK
#define PHMASK 0xFFFF
#endif
#define PON(k) ((PHMASK >> (k)) & 1)
#ifndef REPMASK
#define REPMASK 0
#endif
#define NREP(k) (((REPMASK >> (k)) & 1) ? 2 : 1)
#define RUN (ph >= lo && ph < hi)
#define OPAQ() const int lane = lane_id_v(), tid = wave * 64 + lane; int gw = gw_; asm volatile("" : "+s"(gw)); (void)lane; (void)gw; (void)tid;
#define SEAM() do { if (ph >= lo && ph + 1 < hi) xcd_barrier(xbar, wave); ++ph; } while (0)

    float* CV = (float*)(ws + WS_CV); float* CVP = (float*)(ws + WS_CVP); float* STM = (float*)(ws + WS_STM); float* STS = (float*)(ws + WS_STS); float* GST = (float*)(ws + WS_GST); bf16_t* ZB = (bf16_t*)(ws + WS_ZB);
    if (RUN && PON(0)) for (int rep_ = 0; rep_ < NREP(0); ++rep_) { OPAQ();
        LAS float* scr = (LAS float*)(lds + wave * 16896);
        {
            constexpr int I_IN = 16 * (INC / 32), I_SQ = 16 * 32, I_KV = 16 * 64, I_UP = 16 * 128, I_DN = 64 * 32;
            constexpr int NIT = I_IN + 3 * I_SQ + I_KV + I_UP + I_DN;
            auto mk = [&](int it) -> TDesc {
                const int l = it / NIT; int r = it % NIT; TDesc d; d.gsc = nullptr; d.bsc = nullptr; d.cvp = nullptr; d.K = DM;
                if (r < I_IN) { d.W = args.in[7] + (size_t)l * DM * INC; d.N = INC; d.WT = WIN + (size_t)l * INC * DM; d.item = r;
                    if (l > 0) { d.gsc = args.in[22] + (l - 1) * DM; d.bsc = args.in[23] + (l - 1) * DM; d.cvp = CVP + (size_t)(l * 3 + 0) * 16 * 2 * 4096; } return d; } r -= I_IN;
                if (r < I_SQ) { d.W = args.in[12] + (size_t)l * DM * DM; d.N = DM; d.WT = WMIX + (size_t)l * DM * DM; d.item = r; return d; } r -= I_SQ;
                if (r < I_SQ) { d.W = args.in[15] + (size_t)l * DM * DM; d.N = DM; d.WT = WXQ + (size_t)l * DM * DM; d.item = r;
                    d.gsc = args.in[13] + l * DM; d.bsc = args.in[14] + l * DM; d.cvp = CVP + (size_t)(l * 3 + 1) * 16 * 2 * 4096; return d; } r -= I_SQ;
                if (r < I_SQ) { d.W = args.in[17] + (size_t)l * DM * DM; d.N = DM; d.WT = WXO + (size_t)l * DM * DM; d.item = r; return d; } r -= I_SQ;
                if (r < I_KV) { d.W = args.in[16] + (size_t)l * DM * 2048; d.N = 2048; d.WT = WXKV + (size_t)l * 2048 * DM; d.item = r; return d; } r -= I_KV;
                if (r < I_UP) { d.W = args.in[20] + (size_t)l * DM * FF; d.N = FF; d.WT = WUP + (size_t)l * FF * DM; d.item = r;
                    d.gsc = args.in[18] + l * DM; d.bsc = args.in[19] + l * DM; d.cvp = CVP + (size_t)(l * 3 + 2) * 16 * 2 * 4096; return d; } r -= I_UP;
                d.W = args.in[21] + (size_t)l * FF * DM; d.N = DM; d.K = FF; d.WT = WDN + (size_t)l * DM * FF; d.item = r; return d;
            };
            for (int it = gw; it < DEPTH * NIT; it += 2 * NGW) {
                const bool two = it + NGW < DEPTH * NIT;
                const TDesc da = mk(it), db = mk(two ? it + NGW : it);
                float wa[32], wb[32];
                p0_load(da, wa, lane);
                if (two) p0_load(db, wb, lane);
                p0_finish(da, wa, scr, lane);
                if (two) p0_finish(db, wb, scr + 64 * 33, lane);
            }
        }
#pragma unroll 2
        for (int row = gw; row < MR + 2048; row += NGW) {
            const float* src = row < MP ? args.in[0] + (size_t)row * DM : (row < MR ? args.in[1] + (size_t)(row - MP) * DM : args.in[6] + (size_t)(row - MR) * DM);
            bf16_t* dstp = row < MR ? XB + (size_t)row * DM : MEMB + (size_t)(row - MR) * DM;
            const f32x4* s4 = (const f32x4*)src + lane; u32x2* ob = (u32x2*)dstp + lane;
#pragma unroll
            for (int j = 0; j < 4; ++j) ob[64 * j] = pk4(s4[64 * j]);
        }
        for (int e = bx * 512 + tid; e < DEPTH * 4 * 128 * 128; e += G * 512) { const int s = e & 127, t = (e >> 7) & 127; WSP[e] = s <= t ? (bf16_t)f2bf(args.in[10][e]) : (bf16_t)0; }
        for (int e = bx * 512 + tid; e < 2052 * 8; e += G * 512) {
            const int pi = e >> 3, i = e & 7; const float pos = (float)(pi < 2048 ? pi : 8192 + pi - 2048);
            const float inv = i == 0 ? 1.0f : i == 1 ? 0.19392274474868576f : i == 2 ? 0.03760603093086393f : i == 3 ? 0.007292664737217109f :
                              i == 4 ? 0.001414213562373095f : i == 5 ? 0.0002742481756762073f : i == 6 ? 5.318295896944988e-05f : 1.031338537721246e-05f;
            const float ang = pos * inv;
            const double x = (double)ang, kq = __builtin_rint(x * 0.15915494309189535), rr = (x - kq * 6.283185307179586) , r2 = rr * rr;
            double sn = 0.0, ts = rr, cs = 0.0, tc = 1.0;
            for (int n = 0; n < 16; ++n) { sn += ts; cs += tc; tc *= -r2 / (double)((2 * n + 1) * (2 * n + 2)); ts *= -r2 / (double)((2 * n + 2) * (2 * n + 3)); }
            ROPE[pi * 16 + i] = (float)cs; ROPE[pi * 16 + 8 + i] = (float)sn;
        }
    }
    SEAM();

    int sb = 0;
    for (int l = 0; l < DEPTH; ++l) {
        const float* cvl = CV + (size_t)l * 3 * 2 * 4096;
        if (RUN && PON(1)) for (int rep_ = 0; rep_ < NREP(1); ++rep_) {
            { const bf16_t* Ain = l == 0 ? XB : ZB;
              pg8::Gemm g{Ain, WIN + (size_t)l * INC * DM, MP, INC, DM}; pg8::StaticOrder S; S.init(MP, INC, G, bx);
              EpiFold<FProj> E{FProj{Qb, Kb, Vb, Ub, Gb, ROPE, out, l, GST}, l > 0, STM + (size_t)sb * MP * 32, STS + (size_t)sb * 128 * 128, cvl, cvl + 4096};
              pg8::gemm_phase(lds, g, S, E, wave);
              skinny_gemm<1>(Ain, WIN + (size_t)l * INC * DM, INC, DM, E, lds, G - 1 - bx, G, wave); }
            if (bx >= G - 64) { pg8::Gemm g{MEMB, WXKV + (size_t)l * 2048 * DM, 2048, 2048, DM}; pg8::StaticOrder S; S.init(2048, 2048, 64, bx - (G - 64));
              pg8::EpiWrap<FMkv> E{FMkv{out, MKV, l}};
              pg8::gemm_phase(lds, g, S, E, wave); }
        }
        SEAM();
        if (RUN && PON(2)) for (int rep_ = 0; rep_ < NREP(2); ++rep_) { OPAQ();
            if (l == 0 && rep_ == 0) {
                for (int e = bx * 512 + tid; e < DEPTH * 3 * 2 * 4096; e += G * 512) {
                    const int lw = e / 8192, rem = e % 8192; const float* p = CVP + (size_t)lw * 16 * 8192 + rem; float a = 0.f;
#pragma unroll
                    for (int kb = 0; kb < 16; ++kb) a += p[kb * 8192];
                    CV[e] = a;
                }
            }
            LAS unsigned char* vl = lds + wave * 5120;
            LAS unsigned char* otile = lds + 40960;
            LAS float* lsel = (LAS float*)(lds + 40960 + 98304);
            for (int u = bx; u < DECB * 4; u += G) {
                const int b = u >> 2, hs = u & 3;
                __syncthreads();
                for (int j = wave; j < 12; j += NWAVES) {
                    const int g = j >> 2, qi = j & 3;
                    attn_tile<true>(Qb, Kb, Vb, args.in[2], args.in[3], args.in[4], l, otile + j * 128, lsel + g * 4 + qi, vl, b, g * 4 + hs, qi, 0, lane);
                }
                __syncthreads();
                if (tid < 96) {
                    const int j = tid >> 3, seg = tid & 7, g = j >> 2, qi = j & 3;
                    const float l0 = lsel[qi], l1 = lsel[4 + qi], l2 = lsel[8 + qi], mx = fmaxf(l0, fmaxf(l1, l2));
                    const float e0 = __expf(l0 - mx), e1 = __expf(l1 - mx), e2 = __expf(l2 - mx);
                    const float w = (g == 0 ? e0 : (g == 1 ? e1 : e2)) * __builtin_amdgcn_rcpf(e0 + e1 + e2);
                    const u32x4 v = *(const LAS u32x4*)(otile + j * 128 + seg * 16);
                    u32x4 o; o.x = pk2(bflo(v.x) * w, bfhi(v.x) * w); o.y = pk2(bflo(v.y) * w, bfhi(v.y) * w); o.z = pk2(bflo(v.z) * w, bfhi(v.z) * w); o.w = pk2(bflo(v.w) * w, bfhi(v.w) * w);
                    *(u32x4*)(CAT + ((size_t)MP + b * 4 + qi) * DM + (g * 4 + hs) * 64 + seg * 8) = o;
                }
            }
            for (int u = bx; u < NB * 4 * 8; u += G) {
                const int uu = (G == 256) ? ((u & 7) * 32 + (u >> 3)) : u;
                const int b = uu >> 5, hs = (uu >> 3) & 3, blk = uu & 7;
                __syncthreads();
#pragma unroll 1
                for (int i = 0; i < 6; ++i) {
                    const int j = wave + 8 * i, g = j >> 4, idx = j & 15;
                    const int r = g == 0 ? 0 : (g == 1 ? (idx & 3) : idx), sb = g == 0 ? blk * 16 + idx : (g == 1 ? blk * 4 + (idx >> 2) : blk);
                    const int tk = (((16 * sb + (lane & 15)) << (2 * g)) + r) - 256 * blk;
                    attn_tile<false>(Qb, Kb, Vb, args.in[2], args.in[3], args.in[4], l, otile + (j * 16 + (lane & 15)) * 128, lsel + g * 256 + tk, vl, b, g * 4 + hs, r, sb, lane);
                }
                __syncthreads();
#pragma unroll 2
                for (int p = 0; p < 12; ++p) {
                    const int rowi = (tid >> 3) + 64 * p, seg = tid & 7, j = rowi >> 4, q = rowi & 15, g = j >> 4, idx = j & 15;
                    const int r = g == 0 ? 0 : (g == 1 ? (idx & 3) : idx), sb = g == 0 ? blk * 16 + idx : (g == 1 ? blk * 4 + (idx >> 2) : blk);
                    const int tk = (((16 * sb + q) << (2 * g)) + r) - 256 * blk;
                    const float l0 = lsel[tk], l1 = lsel[256 + tk], l2 = lsel[512 + tk], mx = fmaxf(l0, fmaxf(l1, l2));
                    const float e0 = __expf(l0 - mx), e1 = __expf(l1 - mx), e2 = __expf(l2 - mx);
                    const float w = (g == 0 ? e0 : (g == 1 ? e1 : e2)) * __builtin_amdgcn_rcpf(e0 + e1 + e2);
                    const u32x4 v = *(const LAS u32x4*)(otile + rowi * 128 + seg * 16);
                    u32x4 o; o.x = pk2(bflo(v.x) * w, bfhi(v.x) * w); o.y = pk2(bflo(v.y) * w, bfhi(v.y) * w); o.z = pk2(bflo(v.z) * w, bfhi(v.z) * w); o.w = pk2(bflo(v.w) * w, bfhi(v.w) * w);
                    *(u32x4*)(CAT + ((size_t)b * SEQ + 256 * blk + tk) * DM + (g * 4 + hs) * 64 + seg * 8) = o;
                }
            }
            __syncthreads();
            const float* sg = args.in[8] + l * 256; const float* sb_ = args.in[9] + l * 256;
            for (int b = gw; b < DECB; b += NGW) {
                const f32x4 gg = *(const f32x4*)(sg + 4 * lane), bb = *(const f32x4*)(sb_ + 4 * lane);
                const int g = lane >> 4;
                f32x4 gvv[4];
#pragma unroll
                for (int i = 0; i < 4; ++i) {
                    const size_t row = (size_t)MP + b * 4 + i;
                    const u32x2 raw = *((const u32x2*)(Gb + row * 256) + lane);
                    f32x4 v = (f32x4){bflo(raw.x), bfhi(raw.x), bflo(raw.y), bfhi(raw.y)};
                    const float mean = wave_sum((v.x + v.y) + (v.z + v.w)) * (1.f / 256.f);
                    v = v - mean;
                    const float rstd = 1.f / sqrtf(wave_sum((v.x * v.x + v.y * v.y) + (v.z * v.z + v.w * v.w)) * (1.f / 256.f) + LN_EPS);
                    gvv[i] = v * rstd * gg + bb;
                    *(f32x4*)(out + O9 + (((size_t)l * DECB + b) * 4 + i) * 256 + 4 * lane) = gvv[i];
                }
#pragma unroll
                for (int i = 0; i < 4; ++i) {
                    const size_t row = (size_t)MP + b * 4 + i;
                    const float* wsp = args.in[10] + (((size_t)l * 4 + g) * 128 + i) * 128;
                    const float bs = args.in[11][((size_t)l * 4 + g) * 128 + i];
                    f32x4 mx = (f32x4){bs, bs, bs, bs};
#pragma unroll
                    for (int s = 0; s <= i; ++s) mx = mx + gvv[s] * wsp[s];
                    const u32x2 ur = *((const u32x2*)(Ub + row * 256) + lane);
                    f32x4 u = (f32x4){bflo(ur.x), bfhi(ur.x), bflo(ur.y), bfhi(ur.y)};
                    *((u32x2*)(CAT + row * DM + ATT) + lane) = pk4(u * mx);
                }
            }
            const int nsgu = G == 256 ? (bx < 128 ? 1 : 3) : (128 * 4 - bx + G - 1) / G;
            for (int ui = 0; ui < nsgu; ++ui) {
                const int unit = G == 256 ? (bx < 128 ? bx : 128 + 3 * (bx - 128) + ui) : bx + ui * G;
                const int ck = unit >> 2, g = unit & 3; const size_t R0 = (size_t)ck * 128;
                __syncthreads();
                LAS float* stl = (LAS float*)(lds + 24576);
                if (tid < 128) {
                    const f32x4* p = (const f32x4*)(GST + (R0 + tid) * 8); const f32x4 a = p[0], b = p[1];
                    const float s1 = (a.x + a.z) + (b.x + b.z), s2 = (a.y + a.w) + (b.y + b.w);
                    const float mean = s1 * (1.f / 256.f); stl[2 * tid] = mean; stl[2 * tid + 1] = 1.f / sqrtf(fmaxf(s2 * (1.f / 256.f) - mean * mean, 0.f) + LN_EPS);
                }
                __syncthreads();
                {
                    const int rr = tid >> 2, cs = (tid & 3) * 16; const float mean = stl[2 * rr], rstd = stl[2 * rr + 1];
                    const u32x4* gp = (const u32x4*)(Gb + (R0 + rr) * 256 + g * 64 + cs);
                    const float* sgp = sg + g * 64 + cs; const float* sbp = sb_ + g * 64 + cs;
#pragma unroll
                    for (int q = 0; q < 2; ++q) {
                        const u32x4 raw = gp[q];
                        const f32x4 g0 = *(const f32x4*)(sgp + 8 * q), g1 = *(const f32x4*)(sgp + 8 * q + 4), b0 = *(const f32x4*)(sbp + 8 * q), b1 = *(const f32x4*)(sbp + 8 * q + 4);
                        const f32x4 v0 = ((f32x4){bflo(raw.x), bfhi(raw.x), bflo(raw.y), bfhi(raw.y)} - mean) * rstd * g0 + b0;
                        const f32x4 v1 = ((f32x4){bflo(raw.z), bfhi(raw.z), bflo(raw.w), bfhi(raw.w)} - mean) * rstd * g1 + b1;
                        u32x4 o; o.x = pk2(v0.x, v0.y); o.y = pk2(v0.z, v0.w); o.z = pk2(v1.x, v1.y); o.w = pk2(v1.z, v1.w);
                        *(LAS u32x4*)(lds + rr * 160 + cs * 2 + q * 16) = o;
                    }
                }
                __syncthreads();
                const int fr = lane & 15, fq = lane >> 4, mt = wave;
                f32x4 acc[4];
#pragma unroll
                for (int n = 0; n < 4; ++n) acc[n] = (f32x4){0.f, 0.f, 0.f, 0.f};
                const bf16_t* wrow = WSP + (((size_t)l * 4 + g) * 128 + 16 * mt + fr) * 128;
                const LAS unsigned char* trp = lds + (4 * fq + (fr >> 2)) * 160 + (lane & 3) * 8;
                for (int sk = 0; sk <= (mt >> 1); ++sk) {
                    const u32x2 w0 = *(const u32x2*)(wrow + 32 * sk + 4 * fq), w1 = *(const u32x2*)(wrow + 32 * sk + 16 + 4 * fq);
                    u32x4 wv; wv.x = w0.x; wv.y = w0.y; wv.z = w1.x; wv.w = w1.y;
                    const bf16x8 wb = __builtin_bit_cast(bf16x8, wv);
#pragma unroll
                    for (int n = 0; n < 4; ++n) {
                        const s16x4 lo = vtr(trp + sk * 32 * 160 + n * 32), hi = vtr(trp + sk * 32 * 160 + 16 * 160 + n * 32);
                        bf16x8 va; va[0] = lo[0]; va[1] = lo[1]; va[2] = lo[2]; va[3] = lo[3]; va[4] = hi[0]; va[5] = hi[1]; va[6] = hi[2]; va[7] = hi[3];
                        acc[n] = __builtin_amdgcn_mfma_f32_16x16x32_bf16(va, wb, acc[n], 0, 0, 0);
                    }
                }
                const int t = 16 * mt + fr; const float bs = args.in[11][((size_t)l * 4 + g) * 128 + t];
#pragma unroll
                for (int n = 0; n < 4; ++n) {
                    const u32x2 ur = *(const u32x2*)(Ub + (R0 + t) * 256 + g * 64 + 16 * n + 4 * fq);
                    const f32x4 u = (f32x4){bflo(ur.x), bfhi(ur.x), bflo(ur.y), bfhi(ur.y)};
                    *(u32x2*)(CAT + (R0 + t) * DM + ATT + g * 64 + 16 * n + 4 * fq) = pk4(u * (acc[n] + bs));
                }
            }
        }
        SEAM();
        if (RUN && PON(4)) for (int rep_ = 0; rep_ < NREP(4); ++rep_) {
            pg8::Gemm g{CAT, WMIX + (size_t)l * DM * DM, MP, DM, DM}; pg8::StaticOrder S; S.init(MP, DM, G, bx);
            EpiRes E{l == 0 ? XB : ZB, ZB, l > 0, STM + (size_t)sb * MP * 32, STS + (size_t)sb * 128 * 128, args.in[22] + (l > 0 ? l - 1 : 0) * DM, args.in[23] + (l > 0 ? l - 1 : 0) * DM,
                     STM + (size_t)(sb ^ 1) * MP * 32, STS + (size_t)(sb ^ 1) * 128 * 128};
            pg8::gemm_phase(lds, g, S, E, wave);
            skinny_gemm<4>(CAT, WMIX + (size_t)l * DM * DM, DM, DM, E, lds, bx, G, wave); }
        SEAM(); sb ^= 1;
        if (RUN && PON(6)) for (int rep_ = 0; rep_ < NREP(6); ++rep_) {
            pg8::Gemm g{ZB, WXQ + (size_t)l * DM * DM, MP, DM, DM}; pg8::StaticOrder S; S.init(MP, DM, G, bx);
            EpiFold<FScaleBf> E{FScaleBf{XQ, DM, XQSCALE}, true, STM + (size_t)sb * MP * 32, STS + (size_t)sb * 128 * 128, cvl + 2 * 4096, cvl + 3 * 4096};
            pg8::gemm_phase(lds, g, S, E, wave);
            skinny_gemm<4>(ZB, WXQ + (size_t)l * DM * DM, DM, DM, E, lds, bx, G, wave); }
        SEAM();
        if (RUN && PON(7)) for (int rep_ = 0; rep_ < NREP(7); ++rep_) { OPAQ();
            const float* cmem = args.in[5] + (size_t)l * DECB * 256 * 2048; const bf16_t* MKVl = MKV + (size_t)l * 2048 * 2048;
            constexpr int NU = DECB * 4 + NB * 4 * 16;
            u32x4 kpre[8];
            if (G == 256) {
                const int xcd = bx & 7, slot = bx >> 3, nun = slot < 16 ? 2 : 3;
                for (int i = 0; i < nun; ++i) {
                    int u;
                    if (slot < 16 && i == 0) u = xcd * 16 + slot;
                    else { const int idx = slot < 16 ? slot : 16 + 3 * (slot - 16) + i; u = DECB * 4 + (xcd + 8 * (idx >> 4)) * 16 + (idx & 15); }
                    if (u < DECB * 4) xattn_unit<true>(XQ, MKVl, cmem, XO, lds, u, -1, kpre, wave);
                    else xattn_unit<false>(XQ, MKVl, cmem, XO, lds, u, -1, kpre, wave);
                }
            } else
            for (int u = bx; u < NU; u += G) {
                if (u < DECB * 4) xattn_unit<true>(XQ, MKVl, cmem, XO, lds, u, -1, kpre, wave);
                else xattn_unit<false>(XQ, MKVl, cmem, XO, lds, u, -1, kpre, wave);
            }
            __syncthreads();
        }
        SEAM();
        if (RUN && PON(8)) for (int rep_ = 0; rep_ < NREP(8); ++rep_) {
            pg8::Gemm g{XO, WXO + (size_t)l * DM * DM, MP, DM, DM}; pg8::StaticOrder S; S.init(MP, DM, G, bx);
            EpiRes E{ZB, ZB, true, STM + (size_t)sb * MP * 32, STS + (size_t)sb * 128 * 128, args.in[13] + l * DM, args.in[14] + l * DM,
                     STM + (size_t)(sb ^ 1) * MP * 32, STS + (size_t)(sb ^ 1) * 128 * 128};
            pg8::gemm_phase(lds, g, S, E, wave);
            skinny_gemm<4>(XO, WXO + (size_t)l * DM * DM, DM, DM, E, lds, bx, G, wave); }
        SEAM(); sb ^= 1;
        if (RUN && PON(10)) for (int rep_ = 0; rep_ < NREP(10); ++rep_) {
            pg8::Gemm g{ZB, WUP + (size_t)l * FF * DM, MP, FF, DM}; pg8::StaticOrder S; S.init(MP, FF, G, bx);
            EpiFold<FRelu2> E{FRelu2{H}, true, STM + (size_t)sb * MP * 32, STS + (size_t)sb * 128 * 128, cvl + 4 * 4096, cvl + 5 * 4096};
            pg8::gemm_phase(lds, g, S, E, wave);
            skinny_gemm<1>(ZB, WUP + (size_t)l * FF * DM, FF, DM, E, lds, bx, G, wave); }
        SEAM();
        if (RUN && PON(11)) for (int rep_ = 0; rep_ < NREP(11); ++rep_) {
            pg8::Gemm g{H, WDN + (size_t)l * DM * FF, MP, DM, FF}; pg8::StaticOrder S; S.init(MP, DM, G, bx);
            EpiRes E{ZB, ZB, true, STM + (size_t)sb * MP * 32, STS + (size_t)sb * 128 * 128, args.in[18] + l * DM, args.in[19] + l * DM,
                     STM + (size_t)(sb ^ 1) * MP * 32, STS + (size_t)(sb ^ 1) * 128 * 128};
            pg8::gemm_phase(lds, g, S, E, wave);
            skinny_gemm<4>(H, WDN + (size_t)l * DM * FF, DM, FF, E, lds, bx, G, wave); }
        SEAM(); sb ^= 1;
    }
    if (RUN && PON(12)) for (int rep_ = 0; rep_ < NREP(12); ++rep_) { OPAQ(); final_ln(ZB, args.in[22] + (DEPTH - 1) * DM, args.in[23] + (DEPTH - 1) * DM, out, gw, NGW, lane); }
    SEAM();
#undef RUN
#undef SEAM
}
constexpr int N_PHASES = 2 + DEPTH * 8;

extern "C" void kernel_launch(void* const* d_in, const int* in_sizes, int n_in, void* d_out, int out_size, void* d_ws, size_t ws_size, hipStream_t stream) {
    static int grid = 0;
    if (grid == 0) {
        if (n_in != 24 || ws_size < WS_END) { fprintf(stderr, "kernel_launch: need 24 inputs and %zu bytes of ws (got %d, %zu)\n", (size_t)WS_END, n_in, ws_size); grid = -1; return; }
        int dev = 0, cus = 0, per_cu = 0;
        hipGetDevice(&dev); hipDeviceGetAttribute(&cus, hipDeviceAttributeMultiprocessorCount, dev);
        if (hipFuncSetAttribute((const void*)mega, hipFuncAttributeMaxDynamicSharedMemorySize, LDS_BYTES) != hipSuccess) { fprintf(stderr, "kernel_launch: hipFuncSetAttribute failed\n"); grid = -1; return; }
        hipOccupancyMaxActiveBlocksPerMultiprocessor(&per_cu, (const void*)mega, NWAVES * 64, LDS_BYTES);
        if (per_cu < 1) { fprintf(stderr, "kernel_launch: occupancy query says %d blocks/CU\n", per_cu); per_cu = 1; }
        (void)hipGetLastError();
        grid = cus * 1;
    }
    if (grid < 0) return;
    if (hipMemsetAsync((char*)d_ws + WS_BAR, 0, WS_BAR_BYTES, stream) != hipSuccess) { fprintf(stderr, "kernel_launch: memset failed\n"); return; }
    Args a{};
    for (int i = 0; i < 24; ++i) a.in[i] = (const float*)d_in[i];
    a.out = (float*)d_out; a.ws = (unsigned char*)d_ws;
#if MK_MULTI
    for (int p = 0; p < N_PHASES; ++p) {
        a.ph_lo = p; a.ph_hi = p + 1;
        hipLaunchKernelGGL(mega, dim3(grid), dim3(NWAVES * 64), LDS_BYTES, stream, a);
    }
#else
    a.ph_lo = 0; a.ph_hi = N_PHASES;
    void* kargs[] = {&a};
    hipError_t e = hipLaunchCooperativeKernel((const void*)mega, dim3(grid), dim3(NWAVES * 64), kargs, LDS_BYTES, stream);
    if (e != hipSuccess) fprintf(stderr, "cooperative launch failed: %s (grid %d)\n", hipGetErrorString(e), grid);
#endif
}
```

```cpp
#include <hip/hip_runtime.h>
#include <hip/hip_cooperative_groups.h>
#include <cstdio>
#include <cstdint>
namespace cg = cooperative_groups;

#ifndef MK_MULTI
#define MK_MULTI 0
#endif

#define LAS __attribute__((address_space(3)))
typedef unsigned short bf16_t;
typedef short bf16x8 __attribute__((ext_vector_type(8)));
typedef short s16x4 __attribute__((ext_vector_type(4)));
typedef float f32x4 __attribute__((ext_vector_type(4)));
typedef unsigned u32x4 __attribute__((ext_vector_type(4)));
typedef unsigned u32x2 __attribute__((ext_vector_type(2)));

constexpr int DM = 1024, SEQ = 2048, NB = 8, DEPTH = 2, DECB = 32, DECS = 4;
constexpr int MP = NB * SEQ;
constexpr int MS = DECB * DECS;
constexpr int MR = MP + MS;
constexpr int MT = 16640;
constexpr int INC = 2816, ATT = 768, FF = 4096, NMEM = 256;
constexpr float LN_EPS = 1e-5f;
constexpr float ALPHA = 1.41421356237309515f;
constexpr float LOG2E = 1.4426950408889634f, LN2 = 0.6931471805599453f;
constexpr float QSCALE = 0.125f * LOG2E;
constexpr float XQSCALE = 0.0625f * LOG2E;

constexpr size_t O0 = 0, O1 = 16777216, O2 = 16908288, O3 = 17956864, O4 = 22151168, O5 = 38928384,
                 O6 = 47316992, O7 = 47448064, O8 = 47579136, O9 = 47710208;

constexpr size_t al256(size_t x) { return (x + 255) & ~(size_t)255; }
constexpr size_t WS_BAR = 0, WS_BAR_BYTES = 16384;
constexpr size_t WS_ROPE = 16384;
constexpr size_t WS_WIN = al256(WS_ROPE + 2052 * 16 * 4);
constexpr size_t WS_WMIX = WS_WIN + (size_t)DEPTH * INC * DM * 2;
constexpr size_t WS_WXQ = WS_WMIX + (size_t)DEPTH * DM * DM * 2;
constexpr size_t WS_WXKV = WS_WXQ + (size_t)DEPTH * DM * DM * 2;
constexpr size_t WS_WXO = WS_WXKV + (size_t)DEPTH * 2 * DM * DM * 2;
constexpr size_t WS_WUP = WS_WXO + (size_t)DEPTH * DM * DM * 2;
constexpr size_t WS_WDN = WS_WUP + (size_t)DEPTH * FF * DM * 2;
constexpr size_t WS_WSP = WS_WDN + (size_t)DEPTH * FF * DM * 2;
constexpr size_t WS_MEMB = WS_WSP + (size_t)DEPTH * 4 * 128 * 128 * 2;
constexpr size_t WS_MKV = WS_MEMB + (size_t)2048 * DM * 2;
constexpr size_t WS_CV = WS_MKV + (size_t)DEPTH * 2048 * 2048 * 2;
constexpr size_t WS_CVP = WS_CV + (size_t)DEPTH * 3 * 2 * 4096 * 4;
constexpr size_t WS_STM = WS_CVP + (size_t)DEPTH * 3 * 16 * 2 * 4096 * 4;
constexpr size_t WS_STS = WS_STM + (size_t)2 * MP * 32 * 4;
constexpr size_t WS_GST = WS_STS + (size_t)2 * 128 * 128 * 4;
constexpr size_t WS_ZB = WS_GST + (size_t)MP * 8 * 4;
constexpr size_t WS_XB = WS_ZB + (size_t)MT * DM * 2;
constexpr size_t WS_Q = WS_XB + (size_t)MT * DM * 2;
constexpr size_t WS_K = WS_Q + (size_t)MT * ATT * 2;
constexpr size_t WS_V = WS_K + (size_t)MT * ATT * 2;
constexpr size_t WS_U = WS_V + (size_t)MT * ATT * 2;
constexpr size_t WS_G = WS_U + (size_t)MT * 256 * 2;
constexpr size_t WS_CAT = WS_G + (size_t)MT * 256 * 2;
constexpr size_t WS_LSE = WS_CAT + (size_t)MT * DM * 2;
constexpr size_t WS_XQ = WS_LSE + (size_t)MT * 16 * 4;
constexpr size_t WS_XO = WS_XQ + (size_t)MT * DM * 2;
constexpr size_t WS_H = WS_XO + (size_t)MT * DM * 2;
constexpr size_t WS_END = WS_H + (size_t)MT * FF * 2;

constexpr int LDS_BYTES = 147456;
constexpr int NWAVES = 8;

__device__ __forceinline__ unsigned f2bf(float f) { unsigned u = __builtin_bit_cast(unsigned, f); return (u + 0x7fffu + ((u >> 16) & 1u)) >> 16; }
typedef float f32x2_t __attribute__((ext_vector_type(2))); typedef __bf16 bf16x2_t __attribute__((ext_vector_type(2)));
__device__ __forceinline__ unsigned pk2(float lo, float hi) { const f32x2_t v = {lo, hi}; const bf16x2_t b = __builtin_convertvector(v, bf16x2_t); return __builtin_bit_cast(unsigned, b); }
__device__ __forceinline__ float bf2f(unsigned short h) { return __builtin_bit_cast(float, (unsigned)h << 16); }
__device__ __forceinline__ float bflo(unsigned u) { return __builtin_bit_cast(float, u << 16); }
__device__ __forceinline__ float bfhi(unsigned u) { return __builtin_bit_cast(float, u & 0xffff0000u); }
__device__ __forceinline__ u32x2 pk4(f32x4 v) { u32x2 r; r.x = pk2(v.x, v.y); r.y = pk2(v.z, v.w); return r; }
__device__ __forceinline__ float wave_sum(float v) {
#pragma unroll
    for (int o = 1; o < 64; o <<= 1) v += __shfl_xor(v, o);
    return v;
}
__device__ __forceinline__ float gelu_tanh(float x) {
    const float t = x * (2.302208198f + 0.1029432397f * x * x);
    const float e = __builtin_amdgcn_exp2f(fminf(t, 80.f));
    return x - x * __builtin_amdgcn_rcpf(1.f + e);
}
__device__ __forceinline__ int lane_id_v() { int l; asm volatile("v_mbcnt_lo_u32_b32 %0, -1, 0\n\tv_mbcnt_hi_u32_b32 %0, -1, %0" : "=v"(l)); return l; }
#define LDS_WAIT() asm volatile("s_waitcnt lgkmcnt(0)" ::: "memory")
#define VM_WAIT() asm volatile("s_waitcnt vmcnt(0)" ::: "memory")
__device__ __forceinline__ s16x4 vtr(const LAS unsigned char* p) {
    return __builtin_bit_cast(s16x4, __builtin_amdgcn_ds_read_tr16_b64_v4i16((LAS s16x4*)p));
}


#define XB_TMO      128
#define XB_XCNT(j)  (256  + 64 * (j))
#define XB_XSUB(j)  (1280 + 64 * (j))
#define XB_XGEN(j)  (2304 + 64 * (j))
#define XB_TOP      3328
#define XB_TOPGEN   3392
#define XCD_BAR_WORDS 3456
#define XB_SPIN_CAP (1u << 22)
__device__ __forceinline__ unsigned xb_ld(unsigned* p)              { return __hip_atomic_load(p, __ATOMIC_RELAXED, __HIP_MEMORY_SCOPE_AGENT); }
__device__ __forceinline__ unsigned xb_add(unsigned* p, unsigned v) { return __hip_atomic_fetch_add(p, v, __ATOMIC_RELAXED, __HIP_MEMORY_SCOPE_AGENT); }
__device__ __forceinline__ unsigned xb_xcc_id() { return (unsigned)__builtin_amdgcn_s_getreg((3 << 11) | 20) & 0xFu; }
#define XB_SPIN(cond, bar) do { unsigned _sp = 0; while (cond) { __builtin_amdgcn_s_sleep(1); \
    if ((++_sp & 255u) == 0u) { if (xb_ld(&(bar)[XB_TMO])) break; if (_sp > XB_SPIN_CAP) { atomicAdd(&(bar)[XB_TMO], 1u); break; } } } } while (0)
struct XcdBarrier { unsigned* bar; unsigned x; volatile LAS unsigned* st; };
__device__ __forceinline__ XcdBarrier xcd_barrier_post(unsigned* bar, volatile LAS unsigned* st, int wave) {
    XcdBarrier b; b.bar = bar; b.x = xb_xcc_id(); b.st = st;
    if (wave == 0 && lane_id_v() == 0) (void)xb_add(&bar[XB_XCNT(b.x)], 1u);
    return b;
}
__device__ __forceinline__ void xcd_barrier_complete(unsigned* bar, unsigned x, unsigned& nloc, unsigned& nx) {
    const unsigned G = gridDim.x * gridDim.y * gridDim.z;
    unsigned sum, cnt, mine, sp = 0u;
    for (;;) {
        sum = 0u; cnt = 0u; mine = 0u;
#pragma unroll
        for (unsigned j = 0; j < 16; ++j) { const unsigned c = xb_ld(&bar[XB_XCNT(j)]); sum += c; cnt += (c > 0u) ? 1u : 0u; mine = (j == x) ? c : mine; }
        if (sum == G) break;
        __builtin_amdgcn_s_sleep(1);
        if ((++sp & 255u) == 0u) { if (xb_ld(&bar[XB_TMO])) break; if (sp > XB_SPIN_CAP) { atomicAdd(&bar[XB_TMO], 1u); break; } }
    }
    nloc = mine > 0u ? mine : 1u; nx = cnt > 0u ? cnt : 1u;
}
__device__ __forceinline__ void xcd_barrier(const XcdBarrier& b, int wave) {
    asm volatile("s_waitcnt vmcnt(0)" ::: "memory");
    __syncthreads();
    if (wave == 0 && lane_id_v() == 0) {
        unsigned* bar = b.bar;
        __builtin_amdgcn_s_waitcnt(0);
        unsigned nloc = b.st[0], nx = b.st[1];
        if (nloc == 0u) { xcd_barrier_complete(bar, b.x, nloc, nx); b.st[0] = nloc; b.st[1] = nx; }
        const unsigned old = xb_add(&bar[XB_XSUB(b.x)], 1u);
        const unsigned gen = old / nloc;
        if (old + 1u == (gen + 1u) * nloc) {
            __builtin_amdgcn_fence(__ATOMIC_RELEASE, "agent");
            asm volatile("s_waitcnt vmcnt(0)" ::: "memory");
            const unsigned og = xb_add(&bar[XB_TOP], 1u);
            const unsigned tg = og / nx;
            if (og + 1u == (tg + 1u) * nx) xb_add(&bar[XB_TOPGEN], 1u);
            else XB_SPIN(xb_ld(&bar[XB_TOPGEN]) == tg, bar);
            __builtin_amdgcn_fence(__ATOMIC_ACQUIRE, "agent");
            xb_add(&bar[XB_XGEN(b.x)], 1u);
            asm volatile("s_waitcnt vmcnt(0)" ::: "memory");
        } else {
            XB_SPIN(xb_ld(&bar[XB_XGEN(b.x)]) == gen, bar);
            __builtin_amdgcn_fence(__ATOMIC_ACQUIRE, "agent");
            asm volatile("s_waitcnt vmcnt(0)" ::: "memory");
        }
    }
    __syncthreads();
}

namespace pg8 {
constexpr int BM = 256, BK = 64, HALF = 128, HTB = HALF * BK * 2, NXCD = 8, WGM = 8;
__host__ __device__ __forceinline__ int lds_byte(int r, int c) { const int st = (r >> 4) * 2 + (c >> 5), rr = r & 15, cc = c & 31, ob = rr * 64 + cc * 2; return st * 1024 + (ob ^ (((ob >> 9) & 1) << 5)); }
__host__ __device__ __forceinline__ void stage_rc(int b, int& R, int& C) { const int st = b / 1024, sb = b % 1024, swz = sb ^ (((sb >> 9) & 1) << 5); R = (st >> 1) * 16 + swz / 64; C = (st & 1) * 32 + (swz % 64) / 2; }
struct Unit { int pm, pn; };
struct Gemm { const bf16_t* A; const bf16_t* Bt; int M, N, K; };
struct StaticOrder {
    int nM, nN, nwg, G, c;
    __host__ __device__ void init(int M, int N, int G_, int c_) { nM = M / BM; nN = N / BM; nwg = nM * nN; G = G_; c = c_; }
    __host__ __device__ bool next(int i, Unit& u) const {
        const long L = (long)i * G + c; if (L >= nwg) return false;
        int wgid = (int)L; { const int q = nwg / NXCD, r = nwg % NXCD, xcd = wgid % NXCD, off = wgid / NXCD; wgid = (xcd < r ? xcd * (q + 1) : r * (q + 1) + (xcd - r) * q) + off; }
        const int nig = WGM * nN, gid = wgid / nig, fm = gid * WGM, gsz = (nM - fm) < WGM ? (nM - fm) : WGM;
        u.pm = fm + ((wgid % nig) % gsz); u.pn = (wgid % nig) / gsz; return true;
    }
};

template <class Epi, class Sched>
__device__ __forceinline__ void gemm_phase(LAS unsigned char* lds, const Gemm g, const Sched& S, const Epi& E, int wid) {
    const int lane = lane_id_v(), tid = wid * 64 + lane;
    const int wr = wid >> 2, wc = wid & 3, fr = lane & 15, fq = lane >> 4;
    const int K = g.K, nt = K / BK;
    unsigned voffA[2];
#pragma unroll
    for (int i = 0; i < 2; ++i) { int R, C; stage_rc(tid * 16 + i * 8192, R, C); voffA[i] = (unsigned)(R * K + C) * 2u; }
    const size_t kstep = (size_t)(BK * 2);
    const size_t hstep = (size_t)HALF * K * 2;
    const size_t tstep = 2 * hstep;
    const unsigned ldsw = (unsigned)wid * 1024u;
    const int aoff = lds_byte(wr * 64 + fr, fq * 8), boff = lds_byte(wc * 32 + fr, fq * 8);
#define PG8_SA(b, h) (((b) * 2 + (h)) * HTB)
#define PG8_SB(b, h) ((4 + (b) * 2 + (h)) * HTB)
#define PG8_STAGE(bufoff, gbase) do { _Pragma("unroll") for (int _i = 0; _i < 2; ++_i) \
        __builtin_amdgcn_global_load_lds((const unsigned*)((const char*)(gbase) + voffA[_i]), (LAS unsigned*)(lds + (bufoff) + ldsw + _i * 8192), 16, 0, 0); } while (0)
#define PG8_LDA(dst, b, h) do { _Pragma("unroll") for (int m = 0; m < 4; ++m) _Pragma("unroll") for (int k = 0; k < 2; ++k) dst[m][k] = *(const LAS bf16x8*)(lds + PG8_SA(b, h) + aoff + m * 2048 + k * 1024); } while (0)
#define PG8_LDB(dst, b, h) do { _Pragma("unroll") for (int n = 0; n < 2; ++n) _Pragma("unroll") for (int k = 0; k < 2; ++k) dst[n][k] = *(const LAS bf16x8*)(lds + PG8_SB(b, h) + boff + n * 2048 + k * 1024); } while (0)
#define PG8_MMA(ai, bj, At, Bt) do { __builtin_amdgcn_s_setprio(1); _Pragma("unroll") for (int m = 0; m < 4; ++m) _Pragma("unroll") for (int n = 0; n < 2; ++n) _Pragma("unroll") for (int k = 0; k < 2; ++k) \
        acc[ai][bj][m][n] = __builtin_amdgcn_mfma_f32_16x16x32_bf16(Bt[n][k], At[m][k], acc[ai][bj][m][n], 0, 0, 0); __builtin_amdgcn_s_setprio(0); } while (0)
#define PG8_WAIT_V(n) asm volatile("s_waitcnt vmcnt(" #n ")" ::: "memory")
#define PG8_WAIT_L(n) asm volatile("s_waitcnt lgkmcnt(" #n ")" ::: "memory")
#define PG8_BAR __builtin_amdgcn_s_barrier()
#define PG8_SCHED __builtin_amdgcn_sched_barrier(0)
    Unit cur, nxt; int ui = 0;
    if (!S.next(0, cur)) return;
    f32x4 acc[2][2][4][2];
#pragma unroll
    for (int a = 0; a < 2; ++a)
#pragma unroll
        for (int b = 0; b < 2; ++b)
#pragma unroll
            for (int m = 0; m < 4; ++m)
#pragma unroll
                for (int n = 0; n < 2; ++n) acc[a][b][m][n] = (f32x4){0.f, 0.f, 0.f, 0.f};
    bf16x8 At[4][2], B0[2][2], B1[2][2];
    const char* cA = (const char*)g.A + (size_t)cur.pm * tstep; const char* cB = (const char*)g.Bt + (size_t)cur.pn * tstep;
    PG8_STAGE(PG8_SB(0, 0), cB); PG8_STAGE(PG8_SB(0, 1), cB + hstep); PG8_STAGE(PG8_SA(0, 0), cA); PG8_STAGE(PG8_SA(0, 1), cA + hstep);
    if (wr == 1) PG8_BAR;
    PG8_WAIT_V(2); PG8_BAR;
    PG8_STAGE(PG8_SB(1, 0), cB + kstep); PG8_STAGE(PG8_SA(1, 0), cA + kstep); PG8_STAGE(PG8_SB(1, 1), cB + hstep + kstep);
    PG8_WAIT_V(6); PG8_BAR;
    for (;;) {
        const bool has_next = S.next(ui + 1, nxt);
        const char* nA = has_next ? (const char*)g.A + (size_t)nxt.pm * tstep : cA; const char* nB = has_next ? (const char*)g.Bt + (size_t)nxt.pn * tstep : cB;
        for (int t = 0; t < nt; t += 2) {
            const bool last = (t == nt - 2);
            const char* a1 = cA + (size_t)(t + 1) * kstep;
            const char* a2 = last ? nA : cA + (size_t)(t + 2) * kstep; const char* b2 = last ? nB : cB + (size_t)(t + 2) * kstep;
            const char* a3 = a2 + kstep; const char* b3 = b2 + kstep;
            PG8_LDB(B0, 0, 0); PG8_LDB(B1, 0, 1); PG8_SCHED; PG8_LDA(At, 0, 0); PG8_STAGE(PG8_SA(1, 1), a1 + hstep);
            PG8_WAIT_V(8); PG8_WAIT_L(0); PG8_BAR; PG8_MMA(0, 0, At, B0); PG8_MMA(0, 1, At, B1); PG8_BAR; PG8_SCHED;
            PG8_LDA(At, 0, 1); PG8_STAGE(PG8_SB(0, 0), b2); PG8_STAGE(PG8_SB(0, 1), b2 + hstep); PG8_STAGE(PG8_SA(0, 0), a2);
            PG8_WAIT_V(8); PG8_WAIT_L(0); PG8_BAR; PG8_MMA(1, 0, At, B0); PG8_MMA(1, 1, At, B1); PG8_BAR; PG8_SCHED;
            PG8_LDB(B0, 1, 0); PG8_LDB(B1, 1, 1); PG8_SCHED; PG8_LDA(At, 1, 0); PG8_STAGE(PG8_SA(0, 1), a2 + hstep);
            PG8_WAIT_V(8); PG8_WAIT_L(0); PG8_BAR; PG8_MMA(0, 0, At, B0); PG8_MMA(0, 1, At, B1); PG8_BAR; PG8_SCHED;
            PG8_LDA(At, 1, 1); PG8_STAGE(PG8_SB(1, 0), b3); PG8_STAGE(PG8_SB(1, 1), b3 + hstep); PG8_STAGE(PG8_SA(1, 0), a3);
            PG8_WAIT_V(8); PG8_WAIT_L(0); PG8_BAR; PG8_MMA(1, 0, At, B0); PG8_MMA(1, 1, At, B1); PG8_BAR; PG8_SCHED;
        }
        if (wr == 0) PG8_BAR;
        E(acc, cur, wr, wc, fr, fq);
        if (!has_next) break;
#pragma unroll
        for (int a = 0; a < 2; ++a)
#pragma unroll
            for (int b = 0; b < 2; ++b)
#pragma unroll
                for (int m = 0; m < 4; ++m)
#pragma unroll
                    for (int n = 0; n < 2; ++n) acc[a][b][m][n] = (f32x4){0.f, 0.f, 0.f, 0.f};
        cur = nxt; cA = nA; cB = nB; ++ui;
        if (wr == 1) PG8_BAR;
    }
    PG8_WAIT_V(0);
    PG8_BAR;
#undef PG8_SA
#undef PG8_SB
#undef PG8_STAGE
#undef PG8_LDA
#undef PG8_LDB
#undef PG8_MMA
#undef PG8_WAIT_V
#undef PG8_WAIT_L
#undef PG8_BAR
#undef PG8_SCHED
}

template <class F> struct EpiWrap {
    F f;
    __device__ __forceinline__ void operator()(const f32x4 (&acc)[2][2][4][2], const Unit& u, int wr, int wc, int fr, int fq) const {
#pragma unroll
        for (int bj = 0; bj < 2; ++bj)
#pragma unroll
            for (int n = 0; n < 2; ++n) {
                const int col = u.pn * BM + bj * HALF + wc * 32 + n * 16 + fq * 4;
#pragma unroll
                for (int ai = 0; ai < 2; ++ai)
#pragma unroll
                    for (int m = 0; m < 4; ++m) f(u.pm * BM + ai * HALF + wr * 64 + m * 16 + fr, col, acc[ai][bj][m][n], fq);
            }
    }
};
}

struct FMkv {
    float* out; bf16_t* mkv; int l;
    __device__ __forceinline__ void operator()(int row, int col, f32x4 v, int) const {
        const int c = col;
        *(f32x4*)(out + O5 + ((size_t)l * 2048 + row) * 2048 + c) = v;
        *(u32x2*)(mkv + ((size_t)l * 2048 + row) * 2048 + c) = pk4(v);
    }
};
struct FProj {
    bf16_t *Qb, *Kb, *Vb, *Ub, *Gb; const float* rope; float* out; int l; float* gst;
    __device__ __forceinline__ void kvout(int row, int c, int kv, f32x4 v) const {
        const int head = c >> 6, g = head >> 2, hs = head & 3, dd = c & 63;
        if (row < MP) {
            const int b = row >> 11, t = row & 2047;
            const int win = g == 0 ? 128 : (g == 1 ? 512 : 2048);
            const int tw = t - (2048 - win);
            if (tw >= 0) {
                const size_t base = g == 0 ? O2 : (g == 1 ? O3 : O4);
                *(f32x4*)(out + base + ((((size_t)l * NB + b) * win + tw) * 2 + kv) * 256 + hs * 64 + dd) = v;
            }
        } else if (row < MR) {
            const int r = row - MP;
            const size_t base = g == 0 ? O6 : (g == 1 ? O7 : O8);
            *(f32x4*)(out + base + (((size_t)l * MS + r) * 2 + kv) * 256 + hs * 64 + dd) = v;
        }
    }
    __device__ __forceinline__ void operator()(int row, int col, f32x4 v, int fq, float& s1, float& s2) const {
        if (col < 1536) {
            const bool isk = col >= 768; const int c = isk ? col - 768 : col;
            if ((c & 48) == 0) {
                const int pos = row < MP ? (row & 2047) : 2048 + ((row - MP) & 3);
                const float* rt = rope + pos * 16 + (fq & 1) * 4;
                const f32x4 cs = *(const f32x4*)rt, sn = *(const f32x4*)(rt + 8);
                f32x4 o; o.x = __shfl_xor(v.x, 32); o.y = __shfl_xor(v.y, 32); o.z = __shfl_xor(v.z, 32); o.w = __shfl_xor(v.w, 32);
                if (fq < 2) v = v * cs - o * sn; else v = v * cs + o * sn;
            }
            if (!isk) { *(u32x2*)(Qb + (size_t)row * ATT + c) = pk4(v * QSCALE); }
            else { *(u32x2*)(Kb + (size_t)row * ATT + c) = pk4(v); kvout(row, c, 0, v); }
        } else if (col < 2304) {
            const int c = col - 1536;
            *(u32x2*)(Vb + (size_t)row * ATT + c) = pk4(v); kvout(row, c, 1, v);
        } else {
            f32x4 gl; gl.x = gelu_tanh(v.x); gl.y = gelu_tanh(v.y); gl.z = gelu_tanh(v.z); gl.w = gelu_tanh(v.w);
            if (col < 2560) *(u32x2*)(Ub + (size_t)row * 256 + (col - 2304)) = pk4(gl);
            else { const u32x2 pg = pk4(gl); *(u32x2*)(Gb + (size_t)row * 256 + (col - 2560)) = pg;
                const float z0 = bflo(pg.x), z1 = bfhi(pg.x), z2 = bflo(pg.y), z3 = bfhi(pg.y);
                s1 += (z0 + z1) + (z2 + z3); s2 += (z0 * z0 + z1 * z1) + (z2 * z2 + z3 * z3); }
        }
    }
    __device__ __forceinline__ void finish(const pg8::Unit& u, int wr, int wc, int fr, int fq, float (&s1)[2][4], float (&s2)[2][4]) const {
        if (u.pn != 10) return;
#pragma unroll
        for (int ai = 0; ai < 2; ++ai)
#pragma unroll
            for (int m = 0; m < 4; ++m) {
                float a = s1[ai][m], b = s2[ai][m];
                a += __shfl_xor(a, 16); b += __shfl_xor(b, 16); a += __shfl_xor(a, 32); b += __shfl_xor(b, 32);
                if (fq == 0) { float* p = gst + (size_t)(u.pm * 256 + ai * 128 + wr * 64 + m * 16 + fr) * 8 + wc * 2; p[0] = a; p[1] = b; }
            }
    }
};
__device__ __forceinline__ void stats_main(const float* stm, int row, int fq, float& mu, float& rs) {
    const f32x4* p = (const f32x4*)(stm + (size_t)row * 32 + fq * 8);
    const f32x4 a = p[0], b = p[1];
    float s1 = (a.x + a.z) + (b.x + b.z), s2 = (a.y + a.w) + (b.y + b.w);
    s1 += __shfl_xor(s1, 16); s2 += __shfl_xor(s2, 16); s1 += __shfl_xor(s1, 32); s2 += __shfl_xor(s2, 32);
    mu = s1 * (1.f / DM); rs = 1.f / sqrtf(fmaxf(s2 * (1.f / DM) - mu * mu, 0.f) + LN_EPS);
}
__device__ __forceinline__ void stats_sk(const float* sts, int row, int fq, float& mu, float& rs) {
    const f32x4* p = (const f32x4*)(sts + (size_t)(row - MP) * 128 + fq * 32);
    float s1 = 0.f, s2 = 0.f;
#pragma unroll
    for (int i = 0; i < 8; ++i) { const f32x4 a = p[i]; s1 += a.x + a.z; s2 += a.y + a.w; }
    s1 += __shfl_xor(s1, 16); s2 += __shfl_xor(s2, 16); s1 += __shfl_xor(s1, 32); s2 += __shfl_xor(s2, 32);
    mu = s1 * (1.f / DM); rs = 1.f / sqrtf(fmaxf(s2 * (1.f / DM) - mu * mu, 0.f) + LN_EPS);
}
template <class F> struct EpiFold {
    F f; bool fold; const float* stm; const float* sts; const float* c1; const float* c2;
    __device__ __forceinline__ void operator()(const f32x4 (&acc)[2][2][4][2], const pg8::Unit& u, int wr, int wc, int fr, int fq) const {
        float mu[2][4], rs[2][4], ps1[2][4], ps2[2][4];
#pragma unroll
        for (int ai = 0; ai < 2; ++ai)
#pragma unroll
            for (int m = 0; m < 4; ++m) { ps1[ai][m] = 0.f; ps2[ai][m] = 0.f; mu[ai][m] = 0.f; rs[ai][m] = 1.f; if (fold) stats_main(stm, u.pm * 256 + ai * 128 + wr * 64 + m * 16 + fr, fq, mu[ai][m], rs[ai][m]); }
#pragma unroll
        for (int bj = 0; bj < 2; ++bj)
#pragma unroll
            for (int n = 0; n < 2; ++n) {
                const int col = u.pn * 256 + bj * 128 + wc * 32 + n * 16 + fq * 4;
                f32x4 c1v = (f32x4){0.f, 0.f, 0.f, 0.f}, c2v = c1v;
                if (fold) { c1v = *(const f32x4*)(c1 + col); c2v = *(const f32x4*)(c2 + col); }
#pragma unroll
                for (int ai = 0; ai < 2; ++ai)
#pragma unroll
                    for (int m = 0; m < 4; ++m) {
                        f32x4 v = acc[ai][bj][m][n];
                        if (fold) v = (v - c1v * mu[ai][m]) * rs[ai][m] + c2v;
                        f(u.pm * 256 + ai * 128 + wr * 64 + m * 16 + fr, col, v, fq, ps1[ai][m], ps2[ai][m]);
                    }
            }
        f.finish(u, wr, wc, fr, fq, ps1, ps2);
    }
    __device__ __forceinline__ void sk(int row, int col, f32x4 v, int fq) const {
        if (fold) { float mu, rs; stats_sk(sts, row, fq, mu, rs); const f32x4 c1v = *(const f32x4*)(c1 + col), c2v = *(const f32x4*)(c2 + col); v = (v - c1v * mu) * rs + c2v; }
        float d1 = 0.f, d2 = 0.f; f(row, col, v, fq, d1, d2);
    }
};
struct EpiRes {
    const bf16_t* src; bf16_t* dst; bool ln; const float* stm_p; const float* sts_p; const float* g; const float* b; float* stm_n; float* sts_n;
    __device__ __forceinline__ void operator()(const f32x4 (&acc)[2][2][4][2], const pg8::Unit& u, int wr, int wc, int fr, int fq) const {
#pragma unroll
        for (int ai = 0; ai < 2; ++ai)
#pragma unroll
            for (int m = 0; m < 4; ++m) {
                const int row = u.pm * 256 + ai * 128 + wr * 64 + m * 16 + fr;
                float mu = 0.f, rs = 1.f; if (ln) stats_main(stm_p, row, fq, mu, rs);
                float s1 = 0.f, s2 = 0.f;
#pragma unroll
                for (int bj = 0; bj < 2; ++bj)
#pragma unroll
                    for (int n = 0; n < 2; ++n) {
                        const int col = u.pn * 256 + bj * 128 + wc * 32 + n * 16 + fq * 4;
                        const u32x2 raw = *(const u32x2*)(src + (size_t)row * DM + col);
                        f32x4 x = (f32x4){bflo(raw.x), bfhi(raw.x), bflo(raw.y), bfhi(raw.y)};
                        if (ln) x = (x - mu) * rs * *(const f32x4*)(g + col) + *(const f32x4*)(b + col);
                        const u32x2 pz = pk4(x * ALPHA + acc[ai][bj][m][n]);
                        *(u32x2*)(dst + (size_t)row * DM + col) = pz;
                        const float z0 = bflo(pz.x), z1 = bfhi(pz.x), z2 = bflo(pz.y), z3 = bfhi(pz.y);
                        s1 += (z0 + z1) + (z2 + z3); s2 += (z0 * z0 + z1 * z1) + (z2 * z2 + z3 * z3);
                    }
                s1 += __shfl_xor(s1, 16); s2 += __shfl_xor(s2, 16); s1 += __shfl_xor(s1, 32); s2 += __shfl_xor(s2, 32);
                if (fq == 0) { float* p = stm_n + (size_t)row * 32 + (u.pn * 4 + wc) * 2; p[0] = s1; p[1] = s2; }
            }
    }
    __device__ __forceinline__ void sk(int row, int col, f32x4 v, int fq) const {
        float mu = 0.f, rs = 1.f; if (ln) stats_sk(sts_p, row, fq, mu, rs);
        const u32x2 raw = *(const u32x2*)(src + (size_t)row * DM + col);
        f32x4 x = (f32x4){bflo(raw.x), bfhi(raw.x), bflo(raw.y), bfhi(raw.y)};
        if (ln) x = (x - mu) * rs * *(const f32x4*)(g + col) + *(const f32x4*)(b + col);
        const u32x2 pz = pk4(x * ALPHA + v);
        *(u32x2*)(dst + (size_t)row * DM + col) = pz;
        const float z0 = bflo(pz.x), z1 = bfhi(pz.x), z2 = bflo(pz.y), z3 = bfhi(pz.y);
        float s1 = (z0 + z1) + (z2 + z3), s2 = (z0 * z0 + z1 * z1) + (z2 * z2 + z3 * z3);
        s1 += __shfl_xor(s1, 16); s2 += __shfl_xor(s2, 16); s1 += __shfl_xor(s1, 32); s2 += __shfl_xor(s2, 32);
        if (fq == 0) { float* p = sts_n + (size_t)(row - MP) * 128 + (col >> 4) * 2; p[0] = s1; p[1] = s2; }
    }
};
struct FScaleBf {
    bf16_t* O; int ldc; float s;
    __device__ __forceinline__ void operator()(int row, int col, f32x4 v, int, float&, float&) const { *(u32x2*)(O + (size_t)row * ldc + col) = pk4(v * s); }
    __device__ __forceinline__ void finish(const pg8::Unit&, int, int, int, int, float (&)[2][4], float (&)[2][4]) const {}
};
struct FRelu2 {
    bf16_t* O;
    __device__ __forceinline__ void finish(const pg8::Unit&, int, int, int, int, float (&)[2][4], float (&)[2][4]) const {}
    __device__ __forceinline__ void operator()(int row, int col, f32x4 v, int, float&, float&) const {
        f32x4 r; r.x = fmaxf(v.x, 0.f); r.y = fmaxf(v.y, 0.f); r.z = fmaxf(v.z, 0.f); r.w = fmaxf(v.w, 0.f);
        *(u32x2*)(O + (size_t)row * FF + col) = pk4(r * r);
    }
};

struct TDesc { const float* W; bf16_t* WT; const float* gsc; const float* bsc; float* cvp; int K, N, item; };
__device__ __forceinline__ void p0_load(const TDesc& d, float (&wv)[32], int lane) {
    const int nblk = d.N / 32, kb = d.item / nblk, nb = d.item % nblk, k0 = 64 * kb, n0 = 32 * nb;
#pragma unroll
    for (int i = 0; i < 32; ++i) wv[i] = d.W[(size_t)(k0 + 2 * i + (lane >> 5)) * d.N + n0 + (lane & 31)];
}
__device__ __forceinline__ void p0_finish(const TDesc& d, float (&wv)[32], LAS float* scr, int lane) {
    const int nblk = d.N / 32, kb = d.item / nblk, nb = d.item % nblk, k0 = 64 * kb, n0 = 32 * nb, K = d.K;
    if (d.gsc) {
        float c1 = 0.f, c2 = 0.f;
#pragma unroll
        for (int i = 0; i < 32; ++i) { const int k = k0 + 2 * i + (lane >> 5); c2 += d.bsc[k] * wv[i]; wv[i] *= d.gsc[k]; c1 += bf2f((unsigned short)f2bf(wv[i])); }
        c1 += __shfl_xor(c1, 32); c2 += __shfl_xor(c2, 32);
        if (lane < 32) { float* p = d.cvp + (size_t)kb * 2 * 4096 + n0 + lane; p[0] = c1; p[4096] = c2; }
    }
#pragma unroll
    for (int i = 0; i < 32; ++i) scr[(2 * i + (lane >> 5)) * 33 + (lane & 31)] = wv[i];
    LDS_WAIT(); asm volatile("" ::: "memory");
    const int c = lane & 7;
#pragma unroll
    for (int j = 0; j < 4; ++j) { const int n = (lane >> 3) + 8 * j; const LAS float* sp = scr + (8 * c) * 33 + n;
        u32x4 o; o.x = pk2(sp[0 * 33], sp[1 * 33]); o.y = pk2(sp[2 * 33], sp[3 * 33]); o.z = pk2(sp[4 * 33], sp[5 * 33]); o.w = pk2(sp[6 * 33], sp[7 * 33]);
        *(u32x4*)(d.WT + (size_t)(n0 + n) * K + k0 + 8 * c) = o; }
    LDS_WAIT(); asm volatile("" ::: "memory");
}

struct Args { const float* in[24]; float* out; unsigned char* ws; int ph_lo, ph_hi; };

__device__ __forceinline__ void final_ln(const bf16_t* ZB, const float* gam, const float* bet, float* yout, int gw, int NGW, int lane) {
    f32x4 gv[4], bv[4];
#pragma unroll
    for (int j = 0; j < 4; ++j) { gv[j] = *(const f32x4*)(gam + 4 * lane + 256 * j); bv[j] = *(const f32x4*)(bet + 4 * lane + 256 * j); }
    for (int row = gw; row < MR; row += NGW) {
        const u32x2* zr = (const u32x2*)(ZB + (size_t)row * DM) + lane;
        f32x4 v[4]; float s = 0.f;
#pragma unroll
        for (int j = 0; j < 4; ++j) { const u32x2 raw = zr[64 * j]; v[j] = (f32x4){bflo(raw.x), bfhi(raw.x), bflo(raw.y), bfhi(raw.y)}; s += (v[j].x + v[j].y) + (v[j].z + v[j].w); }
        const float mean = wave_sum(s) * (1.f / DM); float s2 = 0.f;
#pragma unroll
        for (int j = 0; j < 4; ++j) { v[j] = v[j] - mean; s2 += (v[j].x * v[j].x + v[j].y * v[j].y) + (v[j].z * v[j].z + v[j].w * v[j].w); }
        const float rstd = 1.f / sqrtf(wave_sum(s2) * (1.f / DM) + LN_EPS);
        f32x4* o = (f32x4*)(yout + (size_t)row * DM) + lane;
#pragma unroll
        for (int j = 0; j < 4; ++j) o[64 * j] = v[j] * rstd * gv[j] + bv[j];
    }
}

template <bool SAMPLE>
__device__ __forceinline__ void attn_tile(const bf16_t* Qb, const bf16_t* Kb, const bf16_t* Vb, const float* c0, const float* c1, const float* c2, int l,
                                          LAS unsigned char* orow, LAS float* lsep, LAS unsigned char* vl, int b, int h, int rq, int sb, int lane) {
    const int fr = lane & 15, fq = lane >> 4;
    int s0 = 0, r = 0, qi = 0, kt0 = 0;
    const int g = h >> 2, hs = h & 3, dsh = 2 * g;
    const int npre = g == 0 ? 128 : (g == 1 ? 512 : 2048);
    size_t qrow;
    if (SAMPLE) { qi = rq; qrow = (size_t)MP + b * 4 + qi; }
    else { r = rq; s0 = sb * 16; kt0 = sb >= 8 ? 0 : 8 - sb; qrow = (size_t)b * SEQ + (((s0 + fr) << dsh) + r); }
    const float* cbase = SAMPLE ? (g == 0 ? c0 : (g == 1 ? c1 : c2)) + (size_t)(l * DECB + b) * npre * 512 : nullptr;
    const bf16_t* qp = Qb + qrow * ATT + h * 64 + fq * 8;
    const bf16x8 q0 = *(const bf16x8*)qp, q1 = *(const bf16x8*)(qp + 32);
    u32x4 vr[5][4];
#pragma unroll
    for (int kk = 0; kk < 5; ++kk) {
        if (2 * kk + 1 >= kt0) {
#pragma unroll
            for (int it = 0; it < 4; ++it) {
                const int rl = (lane >> 3) + 8 * it, ch = lane & 7;
                u32x4 w;
                if (SAMPLE) {
                    int j = 32 * kk + rl; j = j > 128 ? 128 : j;
                    const int rr = npre + qi - (j << dsh);
                    if (rr >= npre) w = *(const u32x4*)(Vb + ((size_t)MP + b * 4 + (rr - npre)) * ATT + h * 64 + ch * 8);
                    else { const float* vp = cbase + (size_t)rr * 512 + 256 + hs * 64 + ch * 8; const f32x4 a0 = __builtin_nontemporal_load((const f32x4*)vp), a1 = __builtin_nontemporal_load((const f32x4*)(vp + 4));
                        w.x = pk2(a0.x, a0.y); w.y = pk2(a0.z, a0.w); w.z = pk2(a1.x, a1.y); w.w = pk2(a1.z, a1.w); }
                } else {
                    int sk = s0 - 128 + 32 * kk + rl; sk = sk < 0 ? 0 : sk; sk = sk > s0 + 15 ? s0 + 15 : sk;
                    w = *(const u32x4*)(Vb + (unsigned)((b * SEQ + ((sk << dsh) + r)) * ATT + h * 64 + ch * 8));
                }
                vr[kk][it] = w;
            }
        }
    }
    f32x4 S[9];
#pragma unroll
    for (int kt = 0; kt < 9; ++kt) {
        S[kt] = (f32x4){-1e30f, -1e30f, -1e30f, -1e30f};
        if (kt >= kt0) {
            bf16x8 k0, k1;
            if (SAMPLE) {
                int j = 16 * kt + fr; j = j > 128 ? 128 : j;
                const int rr = npre + qi - (j << dsh);
                if (rr >= npre) { const bf16_t* kp = Kb + ((size_t)MP + b * 4 + (rr - npre)) * ATT + h * 64 + fq * 8; k0 = *(const bf16x8*)kp; k1 = *(const bf16x8*)(kp + 32); }
                else { const float* kp = cbase + (size_t)rr * 512 + hs * 64 + fq * 8;
                    const f32x4 a0 = __builtin_nontemporal_load((const f32x4*)kp), a1 = __builtin_nontemporal_load((const f32x4*)(kp + 4)), a2 = __builtin_nontemporal_load((const f32x4*)(kp + 32)), a3 = __builtin_nontemporal_load((const f32x4*)(kp + 36));
                    u32x4 w0, w1; w0.x = pk2(a0.x, a0.y); w0.y = pk2(a0.z, a0.w); w0.z = pk2(a1.x, a1.y); w0.w = pk2(a1.z, a1.w);
                    w1.x = pk2(a2.x, a2.y); w1.y = pk2(a2.z, a2.w); w1.z = pk2(a3.x, a3.y); w1.w = pk2(a3.z, a3.w);
                    k0 = __builtin_bit_cast(bf16x8, w0); k1 = __builtin_bit_cast(bf16x8, w1); }
            } else {
                const int sk = s0 - 128 + 16 * kt + fr;
                const bf16_t* kp = Kb + (unsigned)((b * SEQ + ((sk << dsh) + r)) * ATT + h * 64 + fq * 8);
                k0 = *(const bf16x8*)kp; k1 = *(const bf16x8*)(kp + 32);
            }
            f32x4 a = (f32x4){0.f, 0.f, 0.f, 0.f};
            a = __builtin_amdgcn_mfma_f32_16x16x32_bf16(k0, q0, a, 0, 0, 0);
            a = __builtin_amdgcn_mfma_f32_16x16x32_bf16(k1, q1, a, 0, 0, 0);
            S[kt] = a;
        }
    }
    if (SAMPLE) {
#pragma unroll
        for (int j = 0; j < 4; ++j) if (4 * fq + j > 0) S[8][j] = -1e30f;
    } else {
#pragma unroll
        for (int j = 0; j < 4; ++j) { if (4 * fq + j < fr) S[0][j] = -1e30f; if (4 * fq + j > fr) S[8][j] = -1e30f; }
    }
    float m = -1e30f;
#pragma unroll
    for (int kt = 0; kt < 9; ++kt) m = fmaxf(m, fmaxf(fmaxf(S[kt].x, S[kt].y), fmaxf(S[kt].z, S[kt].w)));
    m = fmaxf(m, __shfl_xor(m, 16)); m = fmaxf(m, __shfl_xor(m, 32));
    float den = 0.f;
#pragma unroll
    for (int kt = 0; kt < 9; ++kt) { S[kt].x = __builtin_amdgcn_exp2f(S[kt].x - m); S[kt].y = __builtin_amdgcn_exp2f(S[kt].y - m); S[kt].z = __builtin_amdgcn_exp2f(S[kt].z - m); S[kt].w = __builtin_amdgcn_exp2f(S[kt].w - m); den += (S[kt].x + S[kt].y) + (S[kt].z + S[kt].w); }
    den += __shfl_xor(den, 16); den += __shfl_xor(den, 32);
    f32x4 O[4];
#pragma unroll
    for (int n = 0; n < 4; ++n) O[n] = (f32x4){0.f, 0.f, 0.f, 0.f};
    const LAS unsigned char* trp = vl + (4 * fq + (fr >> 2)) * 160 + (lane & 3) * 8;
#pragma unroll
    for (int kk = 0; kk < 5; ++kk) {
        if (2 * kk + 1 >= kt0) {
#pragma unroll
            for (int it = 0; it < 4; ++it) *(LAS u32x4*)(vl + ((lane >> 3) + 8 * it) * 160 + (lane & 7) * 16) = vr[kk][it];
            LDS_WAIT();
            u32x4 pw; pw.x = pk2(S[2 * kk].x, S[2 * kk].y); pw.y = pk2(S[2 * kk].z, S[2 * kk].w);
            if (kk < 4) { pw.z = pk2(S[(2 * kk + 1) % 9].x, S[(2 * kk + 1) % 9].y); pw.w = pk2(S[(2 * kk + 1) % 9].z, S[(2 * kk + 1) % 9].w); } else { pw.z = 0u; pw.w = 0u; }
            const bf16x8 pb = __builtin_bit_cast(bf16x8, pw);
#pragma unroll
            for (int n = 0; n < 4; ++n) {
                const s16x4 lo = vtr(trp + n * 32), hi = vtr(trp + 16 * 160 + n * 32);
                bf16x8 va; va[0] = lo[0]; va[1] = lo[1]; va[2] = lo[2]; va[3] = lo[3]; va[4] = hi[0]; va[5] = hi[1]; va[6] = hi[2]; va[7] = hi[3];
                O[n] = __builtin_amdgcn_mfma_f32_16x16x32_bf16(va, pb, O[n], 0, 0, 0);
            }
            LDS_WAIT();
        }
    }
    const float inv = __builtin_amdgcn_rcpf(den);
    if (!SAMPLE || fr == 0) {
#pragma unroll
        for (int n = 0; n < 4; ++n) *(LAS u32x2*)(orow + 32 * n + 8 * fq) = pk4(O[n] * inv);
        if (fq == 0) *lsep = m * LN2 + __logf(den);
    }
}

#define WG_BAR() do { asm volatile("s_waitcnt lgkmcnt(0)" ::: "memory"); __builtin_amdgcn_s_barrier(); asm volatile("" ::: "memory"); } while (0)
constexpr int XA_BUF = 128 * 544;
template <bool SAMPLE>
__device__ __forceinline__ void xa_load(u32x4 (&r)[8], const bf16_t* MKVl, const float* cmem, int b, int h, int kv, int half, int tid) {
#pragma unroll
    for (int ps = 0; ps < 8; ++ps) {
        const int row = half * 128 + ps * 16 + (tid >> 5), ch = tid & 31;
        if (SAMPLE) { const float* p = cmem + ((size_t)(b * 256 + row) * 2 + kv) * 1024 + h * 256 + ch * 8; const f32x4 a0 = __builtin_nontemporal_load((const f32x4*)p), a1 = __builtin_nontemporal_load((const f32x4*)(p + 4));
            r[ps].x = pk2(a0.x, a0.y); r[ps].y = pk2(a0.z, a0.w); r[ps].z = pk2(a1.x, a1.y); r[ps].w = pk2(a1.z, a1.w); }
        else r[ps] = *(const u32x4*)(MKVl + (size_t)(b * 256 + row) * 2048 + kv * 1024 + h * 256 + ch * 8);
    }
}
__device__ __forceinline__ void xa_load_any(u32x4 (&r)[8], const bf16_t* MKVl, const float* cmem, int u, int tid) {
    if (u < DECB * 4) xa_load<true>(r, MKVl, cmem, u >> 2, u & 3, 0, 0, tid);
    else { const int v = u - DECB * 4; xa_load<false>(r, MKVl, cmem, v >> 6, (v >> 4) & 3, 0, 0, tid); }
}
__device__ __forceinline__ void xa_store(const u32x4 (&r)[8], LAS unsigned char* buf, int stride, int tid) {
#pragma unroll
    for (int ps = 0; ps < 8; ++ps) *(LAS u32x4*)(buf + (ps * 16 + (tid >> 5)) * stride + (tid & 31) * 16) = r[ps];
}
__device__ __forceinline__ void xa_s_half(f32x4* S8, const bf16x8 (&qf)[8], const LAS unsigned char* buf, int fr, int fq) {
    bf16x8 kf[2][8];
    const LAS unsigned char* kbase = buf + fr * 528 + fq * 16;
#pragma unroll
    for (int ks = 0; ks < 8; ++ks) kf[0][ks] = *(const LAS bf16x8*)(kbase + ks * 64);
#pragma unroll
    for (int kt = 0; kt < 8; ++kt) {
        if (kt + 1 < 8) {
#pragma unroll
            for (int ks = 0; ks < 8; ++ks) kf[(kt + 1) & 1][ks] = *(const LAS bf16x8*)(kbase + (kt + 1) * 16 * 528 + ks * 64);
        }
        f32x4 a = (f32x4){0.f, 0.f, 0.f, 0.f};
#pragma unroll
        for (int ks = 0; ks < 8; ++ks) a = __builtin_amdgcn_mfma_f32_16x16x32_bf16(kf[kt & 1][ks], qf[ks], a, 0, 0, 0);
        S8[kt] = a;
        __builtin_amdgcn_sched_barrier(0);
    }
}
template <bool SAMPLE>
__device__ __forceinline__ void xattn_unit(const bf16_t* XQ, const bf16_t* MKVl, const float* cmem, bf16_t* XO, LAS unsigned char* lds, int u, int next, u32x4 (&kpre)[8], int wave) {
    const int lane = lane_id_v(), tid = wave * 64 + lane, fr = lane & 15, fq = lane >> 4;
    int b, h; size_t qrow;
    if (SAMPLE) { b = u >> 2; h = u & 3; qrow = (size_t)MP + b * 4 + (fr & 3); }
    else { const int v = u - DECB * 4; b = v >> 6; h = (v >> 4) & 3; qrow = (size_t)b * SEQ + (v & 15) * 128 + wave * 16 + fr; }
    LAS unsigned char* bufA = lds; LAS unsigned char* bufB = lds + XA_BUF;
    bf16x8 qf[8];
    { const bf16_t* qp = XQ + qrow * DM + h * 256 + fq * 8;
#pragma unroll
      for (int ks = 0; ks < 8; ++ks) qf[ks] = *(const bf16x8*)(qp + 32 * ks); }
    u32x4 r[8];
    xa_load<SAMPLE>(kpre, MKVl, cmem, b, h, 0, 0, tid);
    xa_load<SAMPLE>(r, MKVl, cmem, b, h, 0, 1, tid);
    WG_BAR();
    xa_store(kpre, bufA, 528, tid);
    xa_load<SAMPLE>(kpre, MKVl, cmem, b, h, 1, 0, tid);
    WG_BAR();
    f32x4 S[16];
    xa_s_half(S, qf, bufA, fr, fq);
    xa_store(r, bufB, 528, tid);
    xa_load<SAMPLE>(r, MKVl, cmem, b, h, 1, 1, tid);
    WG_BAR();
    xa_s_half(S + 8, qf, bufB, fr, fq);
    float m = -1e30f;
#pragma unroll
    for (int kt = 0; kt < 16; ++kt) m = fmaxf(m, fmaxf(fmaxf(S[kt].x, S[kt].y), fmaxf(S[kt].z, S[kt].w)));
    m = fmaxf(m, __shfl_xor(m, 16)); m = fmaxf(m, __shfl_xor(m, 32));
    float den = 0.f;
#pragma unroll
    for (int kt = 0; kt < 16; ++kt) { S[kt].x = __builtin_amdgcn_exp2f(S[kt].x - m); S[kt].y = __builtin_amdgcn_exp2f(S[kt].y - m); S[kt].z = __builtin_amdgcn_exp2f(S[kt].z - m); S[kt].w = __builtin_amdgcn_exp2f(S[kt].w - m); den += (S[kt].x + S[kt].y) + (S[kt].z + S[kt].w); }
    den += __shfl_xor(den, 16); den += __shfl_xor(den, 32);
    u32x4 P[8];
#pragma unroll
    for (int kk = 0; kk < 8; ++kk) { P[kk].x = pk2(S[2 * kk].x, S[2 * kk].y); P[kk].y = pk2(S[2 * kk].z, S[2 * kk].w); P[kk].z = pk2(S[2 * kk + 1].x, S[2 * kk + 1].y); P[kk].w = pk2(S[2 * kk + 1].z, S[2 * kk + 1].w); }
    WG_BAR();
    xa_store(kpre, bufA, 544, tid);
    WG_BAR();
    const float inv = 1.f / den;
    constexpr int NO = SAMPLE ? 2 : 16;
    f32x4 O[NO];
#pragma unroll
    for (int n = 0; n < NO; ++n) O[n] = (f32x4){0.f, 0.f, 0.f, 0.f};
    const int trofs = (4 * fq + (fr >> 2)) * 544 + (lane & 3) * 8 + (SAMPLE ? 2 * wave * 32 : 0);
#pragma unroll 1
    for (int hf = 0; hf < 2; ++hf) {
        if (hf == 1) {
            xa_store(r, bufB, 544, tid);
            WG_BAR();
        }
        const LAS unsigned char* trp = (hf ? bufB : bufA) + trofs;
#pragma unroll 1
        for (int kk = 0; kk < 4; ++kk) {
            const int kq = hf * 4 + kk;
            u32x4 pw = P[0];
#pragma unroll
            for (int q = 1; q < 8; ++q) if (kq == q) pw = P[q];
            const bf16x8 pb = __builtin_bit_cast(bf16x8, pw);
#pragma unroll
            for (int n = 0; n < NO; ++n) {
                const s16x4 lo = vtr(trp + kk * 32 * 544 + n * 32), hi = vtr(trp + kk * 32 * 544 + 16 * 544 + n * 32);
                bf16x8 va; va[0] = lo[0]; va[1] = lo[1]; va[2] = lo[2]; va[3] = lo[3]; va[4] = hi[0]; va[5] = hi[1]; va[6] = hi[2]; va[7] = hi[3];
                O[n] = __builtin_amdgcn_mfma_f32_16x16x32_bf16(va, pb, O[n], 0, 0, 0);
            }
        }
    }
    if (SAMPLE) { if (fr < 4) { bf16_t* op = XO + qrow * DM + h * 256 + 32 * wave + 4 * fq; *(u32x2*)op = pk4(O[0] * inv); *(u32x2*)(op + 16) = pk4(O[NO > 1 ? 1 : 0] * inv); } }
    else { bf16_t* op = XO + qrow * DM + h * 256 + 4 * fq;
#pragma unroll
        for (int n = 0; n < NO; ++n) *(u32x2*)(op + 16 * n) = pk4(O[n] * inv); }
}

template <int KSPLIT, class F>
__device__ __forceinline__ void skinny_gemm(const bf16_t* A, const bf16_t* Bt, int N, int K, const F& f, LAS unsigned char* lds, int bx, int G, int wave) {
    const int lane = lane_id_v(), fr = lane & 15, fq = lane >> 4;
    constexpr int MTW = 8 / KSPLIT, RG = 8 / MTW;
    const int ntiles = RG * (N / 16), klen = K / KSPLIT;
    for (int t = bx; t < ntiles; t += G) {
        const int rg = t % RG, n0 = (t / RG) * 16;
        const int mt = rg * MTW + (wave % MTW), kq = wave / MTW;
        const bf16_t* ap = A + (size_t)(MP + 16 * mt + fr) * K + kq * klen + 8 * fq;
        const bf16_t* bp = Bt + (size_t)(n0 + fr) * K + kq * klen + 8 * fq;
        f32x4 acc = (f32x4){0.f, 0.f, 0.f, 0.f};
#pragma unroll 16
        for (int k = 0; k < klen; k += 32) {
            const bf16x8 af = *(const bf16x8*)(ap + k), bf = *(const bf16x8*)(bp + k);
            acc = __builtin_amdgcn_mfma_f32_16x16x32_bf16(bf, af, acc, 0, 0, 0);
        }
        if (KSPLIT > 1) {
            __syncthreads();
            *(LAS f32x4*)(lds + wave * 1024 + lane * 16) = acc;
            __syncthreads();
            if (kq == 0) {
#pragma unroll
                for (int q = 1; q < KSPLIT; ++q) acc = acc + *(const LAS f32x4*)(lds + (wave + q * MTW) * 1024 + lane * 16);
                f.sk(MP + 16 * mt + fr, n0 + 4 * fq, acc, fq);
            }
        } else f.sk(MP + 16 * mt + fr, n0 + 4 * fq, acc, fq);
    }
}

__global__ void __launch_bounds__(NWAVES * 64, 2) mega(Args args) {
    extern __shared__ __attribute__((aligned(16))) unsigned char lds_raw[];
    LAS unsigned char* lds = (LAS unsigned char*)lds_raw;
    const int wave = __builtin_amdgcn_readfirstlane((int)threadIdx.x >> 6);
    const int G = gridDim.x, bx = blockIdx.x;
    const int gw_ = bx * NWAVES + wave, NGW = G * NWAVES;
    unsigned char* ws = args.ws; float* out = args.out;
    float* ROPE = (float*)(ws + WS_ROPE);
    bf16_t* WIN = (bf16_t*)(ws + WS_WIN); bf16_t* WMIX = (bf16_t*)(ws + WS_WMIX); bf16_t* WXQ = (bf16_t*)(ws + WS_WXQ); bf16_t* WXKV = (bf16_t*)(ws + WS_WXKV);
    bf16_t* WXO = (bf16_t*)(ws + WS_WXO); bf16_t* WUP = (bf16_t*)(ws + WS_WUP); bf16_t* WDN = (bf16_t*)(ws + WS_WDN); bf16_t* WSP = (bf16_t*)(ws + WS_WSP);
    bf16_t* MEMB = (bf16_t*)(ws + WS_MEMB); bf16_t* MKV = (bf16_t*)(ws + WS_MKV);
    bf16_t* XB = (bf16_t*)(ws + WS_XB);
    bf16_t* Qb = (bf16_t*)(ws + WS_Q); bf16_t* Kb = (bf16_t*)(ws + WS_K); bf16_t* Vb = (bf16_t*)(ws + WS_V); bf16_t* Ub = (bf16_t*)(ws + WS_U); bf16_t* Gb = (bf16_t*)(ws + WS_G);
    bf16_t* CAT = (bf16_t*)(ws + WS_CAT); float* LSE = (float*)(ws + WS_LSE);
    bf16_t* XQ = (bf16_t*)(ws + WS_XQ); bf16_t* XO = (bf16_t*)(ws + WS_XO); bf16_t* H = (bf16_t*)(ws + WS_H);
    const int lo = args.ph_lo, hi = args.ph_hi;
    int ph = 0;
    cg::grid_group grid = cg::this_grid();
    volatile LAS unsigned* misc = (volatile LAS unsigned*)(lds + LDS_BYTES - 64);
    if (wave == 0) { const int l0 = lane_id_v(); if (l0 < 2) misc[l0] = 0u; }
    __syncthreads();
    XcdBarrier xbar; xbar.bar = (unsigned*)(ws + WS_BAR); xbar.x = 0; xbar.st = misc;
    if (hi - lo > 1) xbar = xcd_barrier_post((unsigned*)(ws + WS_BAR), misc, wave);
    if (lo < 0) grid.sync();
#ifndef PHMASK
#define PHMASK 0xFFFF
#endif
#define PON(k) ((PHMASK >> (k)) & 1)
#ifndef REPMASK
#define REPMASK 0
#endif
#define NREP(k) (((REPMASK >> (k)) & 1) ? 2 : 1)
#define RUN (ph >= lo && ph < hi)
#define OPAQ() const int lane = lane_id_v(), tid = wave * 64 + lane; int gw = gw_; asm volatile("" : "+s"(gw)); (void)lane; (void)gw; (void)tid;
#define SEAM() do { if (ph >= lo && ph + 1 < hi) xcd_barrier(xbar, wave); ++ph; } while (0)

    float* CV = (float*)(ws + WS_CV); float* CVP = (float*)(ws + WS_CVP); float* STM = (float*)(ws + WS_STM); float* STS = (float*)(ws + WS_STS); float* GST = (float*)(ws + WS_GST); bf16_t* ZB = (bf16_t*)(ws + WS_ZB);
    if (RUN && PON(0)) for (int rep_ = 0; rep_ < NREP(0); ++rep_) { OPAQ();
        LAS float* scr = (LAS float*)(lds + wave * 16896);
        {
            constexpr int I_IN = 16 * (INC / 32), I_SQ = 16 * 32, I_KV = 16 * 64, I_UP = 16 * 128, I_DN = 64 * 32;
            constexpr int NIT = I_IN + 3 * I_SQ + I_KV + I_UP + I_DN;
            auto mk = [&](int it) -> TDesc {
                const int l = it / NIT; int r = it % NIT; TDesc d; d.gsc = nullptr; d.bsc = nullptr; d.cvp = nullptr; d.K = DM;
                if (r < I_IN) { d.W = args.in[7] + (size_t)l * DM * INC; d.N = INC; d.WT = WIN + (size_t)l * INC * DM; d.item = r;
                    if (l > 0) { d.gsc = args.in[22] + (l - 1) * DM; d.bsc = args.in[23] + (l - 1) * DM; d.cvp = CVP + (size_t)(l * 3 + 0) * 16 * 2 * 4096; } return d; } r -= I_IN;
                if (r < I_SQ) { d.W = args.in[12] + (size_t)l * DM * DM; d.N = DM; d.WT = WMIX + (size_t)l * DM * DM; d.item = r; return d; } r -= I_SQ;
                if (r < I_SQ) { d.W = args.in[15] + (size_t)l * DM * DM; d.N = DM; d.WT = WXQ + (size_t)l * DM * DM; d.item = r;
                    d.gsc = args.in[13] + l * DM; d.bsc = args.in[14] + l * DM; d.cvp = CVP + (size_t)(l * 3 + 1) * 16 * 2 * 4096; return d; } r -= I_SQ;
                if (r < I_SQ) { d.W = args.in[17] + (size_t)l * DM * DM; d.N = DM; d.WT = WXO + (size_t)l * DM * DM; d.item = r; return d; } r -= I_SQ;
                if (r < I_KV) { d.W = args.in[16] + (size_t)l * DM * 2048; d.N = 2048; d.WT = WXKV + (size_t)l * 2048 * DM; d.item = r; return d; } r -= I_KV;
                if (r < I_UP) { d.W = args.in[20] + (size_t)l * DM * FF; d.N = FF; d.WT = WUP + (size_t)l * FF * DM; d.item = r;
                    d.gsc = args.in[18] + l * DM; d.bsc = args.in[19] + l * DM; d.cvp = CVP + (size_t)(l * 3 + 2) * 16 * 2 * 4096; return d; } r -= I_UP;
                d.W = args.in[21] + (size_t)l * FF * DM; d.N = DM; d.K = FF; d.WT = WDN + (size_t)l * DM * FF; d.item = r; return d;
            };
            for (int it = gw; it < DEPTH * NIT; it += 2 * NGW) {
                const bool two = it + NGW < DEPTH * NIT;
                const TDesc da = mk(it), db = mk(two ? it + NGW : it);
                float wa[32], wb[32];
                p0_load(da, wa, lane);
                if (two) p0_load(db, wb, lane);
                p0_finish(da, wa, scr, lane);
                if (two) p0_finish(db, wb, scr + 64 * 33, lane);
            }
        }
#pragma unroll 2
        for (int row = gw; row < MR + 2048; row += NGW) {
            const float* src = row < MP ? args.in[0] + (size_t)row * DM : (row < MR ? args.in[1] + (size_t)(row - MP) * DM : args.in[6] + (size_t)(row - MR) * DM);
            bf16_t* dstp = row < MR ? XB + (size_t)row * DM : MEMB + (size_t)(row - MR) * DM;
            const f32x4* s4 = (const f32x4*)src + lane; u32x2* ob = (u32x2*)dstp + lane;
#pragma unroll
            for (int j = 0; j < 4; ++j) ob[64 * j] = pk4(s4[64 * j]);
        }
        for (int e = bx * 512 + tid; e < DEPTH * 4 * 128 * 128; e += G * 512) { const int s = e & 127, t = (e >> 7) & 127; WSP[e] = s <= t ? (bf16_t)f2bf(args.in[10][e]) : (bf16_t)0; }
        for (int e = bx * 512 + tid; e < 2052 * 8; e += G * 512) {
            const int pi = e >> 3, i = e & 7; const float pos = (float)(pi < 2048 ? pi : 8192 + pi - 2048);
            const float inv = i == 0 ? 1.0f : i == 1 ? 0.19392274474868576f : i == 2 ? 0.03760603093086393f : i == 3 ? 0.007292664737217109f :
                              i == 4 ? 0.001414213562373095f : i == 5 ? 0.0002742481756762073f : i == 6 ? 5.318295896944988e-05f : 1.031338537721246e-05f;
            const float ang = pos * inv;
            const double x = (double)ang, kq = __builtin_rint(x * 0.15915494309189535), rr = (x - kq * 6.283185307179586) , r2 = rr * rr;
            double sn = 0.0, ts = rr, cs = 0.0, tc = 1.0;
            for (int n = 0; n < 16; ++n) { sn += ts; cs += tc; tc *= -r2 / (double)((2 * n + 1) * (2 * n + 2)); ts *= -r2 / (double)((2 * n + 2) * (2 * n + 3)); }
            ROPE[pi * 16 + i] = (float)cs; ROPE[pi * 16 + 8 + i] = (float)sn;
        }
    }
    SEAM();

    int sb = 0;
    for (int l = 0; l < DEPTH; ++l) {
        const float* cvl = CV + (size_t)l * 3 * 2 * 4096;
        if (RUN && PON(1)) for (int rep_ = 0; rep_ < NREP(1); ++rep_) {
            { const bf16_t* Ain = l == 0 ? XB : ZB;
              pg8::Gemm g{Ain, WIN + (size_t)l * INC * DM, MP, INC, DM}; pg8::StaticOrder S; S.init(MP, INC, G, bx);
              EpiFold<FProj> E{FProj{Qb, Kb, Vb, Ub, Gb, ROPE, out, l, GST}, l > 0, STM + (size_t)sb * MP * 32, STS + (size_t)sb * 128 * 128, cvl, cvl + 4096};
              pg8::gemm_phase(lds, g, S, E, wave);
              skinny_gemm<1>(Ain, WIN + (size_t)l * INC * DM, INC, DM, E, lds, G - 1 - bx, G, wave); }
            if (bx >= G - 64) { pg8::Gemm g{MEMB, WXKV + (size_t)l * 2048 * DM, 2048, 2048, DM}; pg8::StaticOrder S; S.init(2048, 2048, 64, bx - (G - 64));
              pg8::EpiWrap<FMkv> E{FMkv{out, MKV, l}};
              pg8::gemm_phase(lds, g, S, E, wave); }
        }
        SEAM();
        if (RUN && PON(2)) for (int rep_ = 0; rep_ < NREP(2); ++rep_) { OPAQ();
            if (l == 0 && rep_ == 0) {
                for (int e = bx * 512 + tid; e < DEPTH * 3 * 2 * 4096; e += G * 512) {
                    const int lw = e / 8192, rem = e % 8192; const float* p = CVP + (size_t)lw * 16 * 8192 + rem; float a = 0.f;
#pragma unroll
                    for (int kb = 0; kb < 16; ++kb) a += p[kb * 8192];
                    CV[e] = a;
                }
            }
            LAS unsigned char* vl = lds + wave * 5120;
            LAS unsigned char* otile = lds + 40960;
            LAS float* lsel = (LAS float*)(lds + 40960 + 98304);
            for (int u = bx; u < DECB * 4; u += G) {
                const int b = u >> 2, hs = u & 3;
                __syncthreads();
                for (int j = wave; j < 12; j += NWAVES) {
                    const int g = j >> 2, qi = j & 3;
                    attn_tile<true>(Qb, Kb, Vb, args.in[2], args.in[3], args.in[4], l, otile + j * 128, lsel + g * 4 + qi, vl, b, g * 4 + hs, qi, 0, lane);
                }
                __syncthreads();
                if (tid < 96) {
                    const int j = tid >> 3, seg = tid & 7, g = j >> 2, qi = j & 3;
                    const float l0 = lsel[qi], l1 = lsel[4 + qi], l2 = lsel[8 + qi], mx = fmaxf(l0, fmaxf(l1, l2));
                    const float e0 = __expf(l0 - mx), e1 = __expf(l1 - mx), e2 = __expf(l2 - mx);
                    const float w = (g == 0 ? e0 : (g == 1 ? e1 : e2)) * __builtin_amdgcn_rcpf(e0 + e1 + e2);
                    const u32x4 v = *(const LAS u32x4*)(otile + j * 128 + seg * 16);
                    u32x4 o; o.x = pk2(bflo(v.x) * w, bfhi(v.x) * w); o.y = pk2(bflo(v.y) * w, bfhi(v.y) * w); o.z = pk2(bflo(v.z) * w, bfhi(v.z) * w); o.w = pk2(bflo(v.w) * w, bfhi(v.w) * w);
                    *(u32x4*)(CAT + ((size_t)MP + b * 4 + qi) * DM + (g * 4 + hs) * 64 + seg * 8) = o;
                }
            }
            for (int u = bx; u < NB * 4 * 8; u += G) {
                const int uu = (G == 256) ? ((u & 7) * 32 + (u >> 3)) : u;
                const int b = uu >> 5, hs = (uu >> 3) & 3, blk = uu & 7;
                __syncthreads();
#pragma unroll 1
                for (int i = 0; i < 6; ++i) {
                    const int j = wave + 8 * i, g = j >> 4, idx = j & 15;
                    const int r = g == 0 ? 0 : (g == 1 ? (idx & 3) : idx), sb = g == 0 ? blk * 16 + idx : (g == 1 ? blk * 4 + (idx >> 2) : blk);
                    const int tk = (((16 * sb + (lane & 15)) << (2 * g)) + r) - 256 * blk;
                    attn_tile<false>(Qb, Kb, Vb, args.in[2], args.in[3], args.in[4], l, otile + (j * 16 + (lane & 15)) * 128, lsel + g * 256 + tk, vl, b, g * 4 + hs, r, sb, lane);
                }
                __syncthreads();
#pragma unroll 2
                for (int p = 0; p < 12; ++p) {
                    const int rowi = (tid >> 3) + 64 * p, seg = tid & 7, j = rowi >> 4, q = rowi & 15, g = j >> 4, idx = j & 15;
                    const int r = g == 0 ? 0 : (g == 1 ? (idx & 3) : idx), sb = g == 0 ? blk * 16 + idx : (g == 1 ? blk * 4 + (idx >> 2) : blk);
                    const int tk = (((16 * sb + q) << (2 * g)) + r) - 256 * blk;
                    const float l0 = lsel[tk], l1 = lsel[256 + tk], l2 = lsel[512 + tk], mx = fmaxf(l0, fmaxf(l1, l2));
                    const float e0 = __expf(l0 - mx), e1 = __expf(l1 - mx), e2 = __expf(l2 - mx);
                    const float w = (g == 0 ? e0 : (g == 1 ? e1 : e2)) * __builtin_amdgcn_rcpf(e0 + e1 + e2);
                    const u32x4 v = *(const LAS u32x4*)(otile + rowi * 128 + seg * 16);
                    u32x4 o; o.x = pk2(bflo(v.x) * w, bfhi(v.x) * w); o.y = pk2(bflo(v.y) * w, bfhi(v.y) * w); o.z = pk2(bflo(v.z) * w, bfhi(v.z) * w); o.w = pk2(bflo(v.w) * w, bfhi(v.w) * w);
                    *(u32x4*)(CAT + ((size_t)b * SEQ + 256 * blk + tk) * DM + (g * 4 + hs) * 64 + seg * 8) = o;
                }
            }
            __syncthreads();
            const float* sg = args.in[8] + l * 256; const float* sb_ = args.in[9] + l * 256;
            for (int b = gw; b < DECB; b += NGW) {
                const f32x4 gg = *(const f32x4*)(sg + 4 * lane), bb = *(const f32x4*)(sb_ + 4 * lane);
                const int g = lane >> 4;
                f32x4 gvv[4];
#pragma unroll
                for (int i = 0; i < 4; ++i) {
                    const size_t row = (size_t)MP + b * 4 + i;
                    const u32x2 raw = *((const u32x2*)(Gb + row * 256) + lane);
                    f32x4 v = (f32x4){bflo(raw.x), bfhi(raw.x), bflo(raw.y), bfhi(raw.y)};
                    const float mean = wave_sum((v.x + v.y) + (v.z + v.w)) * (1.f / 256.f);
                    v = v - mean;
                    const float rstd = 1.f / sqrtf(wave_sum((v.x * v.x + v.y * v.y) + (v.z * v.z + v.w * v.w)) * (1.f / 256.f) + LN_EPS);
                    gvv[i] = v * rstd * gg + bb;
                    *(f32x4*)(out + O9 + (((size_t)l * DECB + b) * 4 + i) * 256 + 4 * lane) = gvv[i];
                }
#pragma unroll
                for (int i = 0; i < 4; ++i) {
                    const size_t row = (size_t)MP + b * 4 + i;
                    const float* wsp = args.in[10] + (((size_t)l * 4 + g) * 128 + i) * 128;
                    const float bs = args.in[11][((size_t)l * 4 + g) * 128 + i];
                    f32x4 mx = (f32x4){bs, bs, bs, bs};
#pragma unroll
                    for (int s = 0; s <= i; ++s) mx = mx + gvv[s] * wsp[s];
                    const u32x2 ur = *((const u32x2*)(Ub + row * 256) + lane);
                    f32x4 u = (f32x4){bflo(ur.x), bfhi(ur.x), bflo(ur.y), bfhi(ur.y)};
                    *((u32x2*)(CAT + row * DM + ATT) + lane) = pk4(u * mx);
                }
            }
            const int nsgu = G == 256 ? (bx < 128 ? 1 : 3) : (128 * 4 - bx + G - 1) / G;
            for (int ui = 0; ui < nsgu; ++ui) {
                const int unit = G == 256 ? (bx < 128 ? bx : 128 + 3 * (bx - 128) + ui) : bx + ui * G;
                const int ck = unit >> 2, g = unit & 3; const size_t R0 = (size_t)ck * 128;
                __syncthreads();
                LAS float* stl = (LAS float*)(lds + 24576);
                if (tid < 128) {
                    const f32x4* p = (const f32x4*)(GST + (R0 + tid) * 8); const f32x4 a = p[0], b = p[1];
                    const float s1 = (a.x + a.z) + (b.x + b.z), s2 = (a.y + a.w) + (b.y + b.w);
                    const float mean = s1 * (1.f / 256.f); stl[2 * tid] = mean; stl[2 * tid + 1] = 1.f / sqrtf(fmaxf(s2 * (1.f / 256.f) - mean * mean, 0.f) + LN_EPS);
                }
                __syncthreads();
                {
                    const int rr = tid >> 2, cs = (tid & 3) * 16; const float mean = stl[2 * rr], rstd = stl[2 * rr + 1];
                    const u32x4* gp = (const u32x4*)(Gb + (R0 + rr) * 256 + g * 64 + cs);
                    const float* sgp = sg + g * 64 + cs; const float* sbp = sb_ + g * 64 + cs;
#pragma unroll
                    for (int q = 0; q < 2; ++q) {
                        const u32x4 raw = gp[q];
                        const f32x4 g0 = *(const f32x4*)(sgp + 8 * q), g1 = *(const f32x4*)(sgp + 8 * q + 4), b0 = *(const f32x4*)(sbp + 8 * q), b1 = *(const f32x4*)(sbp + 8 * q + 4);
                        const f32x4 v0 = ((f32x4){bflo(raw.x), bfhi(raw.x), bflo(raw.y), bfhi(raw.y)} - mean) * rstd * g0 + b0;
                        const f32x4 v1 = ((f32x4){bflo(raw.z), bfhi(raw.z), bflo(raw.w), bfhi(raw.w)} - mean) * rstd * g1 + b1;
                        u32x4 o; o.x = pk2(v0.x, v0.y); o.y = pk2(v0.z, v0.w); o.z = pk2(v1.x, v1.y); o.w = pk2(v1.z, v1.w);
                        *(LAS u32x4*)(lds + rr * 160 + cs * 2 + q * 16) = o;
                    }
                }
                __syncthreads();
                const int fr = lane & 15, fq = lane >> 4, mt = wave;
                f32x4 acc[4];
#pragma unroll
                for (int n = 0; n < 4; ++n) acc[n] = (f32x4){0.f, 0.f, 0.f, 0.f};
                const bf16_t* wrow = WSP + (((size_t)l * 4 + g) * 128 + 16 * mt + fr) * 128;
                const LAS unsigned char* trp = lds + (4 * fq + (fr >> 2)) * 160 + (lane & 3) * 8;
                for (int sk = 0; sk <= (mt >> 1); ++sk) {
                    const u32x2 w0 = *(const u32x2*)(wrow + 32 * sk + 4 * fq), w1 = *(const u32x2*)(wrow + 32 * sk + 16 + 4 * fq);
                    u32x4 wv; wv.x = w0.x; wv.y = w0.y; wv.z = w1.x; wv.w = w1.y;
                    const bf16x8 wb = __builtin_bit_cast(bf16x8, wv);
#pragma unroll
                    for (int n = 0; n < 4; ++n) {
                        const s16x4 lo = vtr(trp + sk * 32 * 160 + n * 32), hi = vtr(trp + sk * 32 * 160 + 16 * 160 + n * 32);
                        bf16x8 va; va[0] = lo[0]; va[1] = lo[1]; va[2] = lo[2]; va[3] = lo[3]; va[4] = hi[0]; va[5] = hi[1]; va[6] = hi[2]; va[7] = hi[3];
                        acc[n] = __builtin_amdgcn_mfma_f32_16x16x32_bf16(va, wb, acc[n], 0, 0, 0);
                    }
                }
                const int t = 16 * mt + fr; const float bs = args.in[11][((size_t)l * 4 + g) * 128 + t];
#pragma unroll
                for (int n = 0; n < 4; ++n) {
                    const u32x2 ur = *(const u32x2*)(Ub + (R0 + t) * 256 + g * 64 + 16 * n + 4 * fq);
                    const f32x4 u = (f32x4){bflo(ur.x), bfhi(ur.x), bflo(ur.y), bfhi(ur.y)};
                    *(u32x2*)(CAT + (R0 + t) * DM + ATT + g * 64 + 16 * n + 4 * fq) = pk4(u * (acc[n] + bs));
                }
            }
        }
        SEAM();
        if (RUN && PON(4)) for (int rep_ = 0; rep_ < NREP(4); ++rep_) {
            pg8::Gemm g{CAT, WMIX + (size_t)l * DM * DM, MP, DM, DM}; pg8::StaticOrder S; S.init(MP, DM, G, bx);
            EpiRes E{l == 0 ? XB : ZB, ZB, l > 0, STM + (size_t)sb * MP * 32, STS + (size_t)sb * 128 * 128, args.in[22] + (l > 0 ? l - 1 : 0) * DM, args.in[23] + (l > 0 ? l - 1 : 0) * DM,
                     STM + (size_t)(sb ^ 1) * MP * 32, STS + (size_t)(sb ^ 1) * 128 * 128};
            pg8::gemm_phase(lds, g, S, E, wave);
            skinny_gemm<4>(CAT, WMIX + (size_t)l * DM * DM, DM, DM, E, lds, bx, G, wave); }
        SEAM(); sb ^= 1;
        if (RUN && PON(6)) for (int rep_ = 0; rep_ < NREP(6); ++rep_) {
            pg8::Gemm g{ZB, WXQ + (size_t)l * DM * DM, MP, DM, DM}; pg8::StaticOrder S; S.init(MP, DM, G, bx);
            EpiFold<FScaleBf> E{FScaleBf{XQ, DM, XQSCALE}, true, STM + (size_t)sb * MP * 32, STS + (size_t)sb * 128 * 128, cvl + 2 * 4096, cvl + 3 * 4096};
            pg8::gemm_phase(lds, g, S, E, wave);
            skinny_gemm<4>(ZB, WXQ + (size_t)l * DM * DM, DM, DM, E, lds, bx, G, wave); }
        SEAM();
        if (RUN && PON(7)) for (int rep_ = 0; rep_ < NREP(7); ++rep_) { OPAQ();
            const float* cmem = args.in[5] + (size_t)l * DECB * 256 * 2048; const bf16_t* MKVl = MKV + (size_t)l * 2048 * 2048;
            constexpr int NU = DECB * 4 + NB * 4 * 16;
            u32x4 kpre[8];
            if (G == 256) {
                const int xcd = bx & 7, slot = bx >> 3, nun = slot < 16 ? 2 : 3;
                for (int i = 0; i < nun; ++i) {
                    int u;
                    if (slot < 16 && i == 0) u = xcd * 16 + slot;
                    else { const int idx = slot < 16 ? slot : 16 + 3 * (slot - 16) + i; u = DECB * 4 + (xcd + 8 * (idx >> 4)) * 16 + (idx & 15); }
                    if (u < DECB * 4) xattn_unit<true>(XQ, MKVl, cmem, XO, lds, u, -1, kpre, wave);
                    else xattn_unit<false>(XQ, MKVl, cmem, XO, lds, u, -1, kpre, wave);
                }
            } else
            for (int u = bx; u < NU; u += G) {
                if (u < DECB * 4) xattn_unit<true>(XQ, MKVl, cmem, XO, lds, u, -1, kpre, wave);
                else xattn_unit<false>(XQ, MKVl, cmem, XO, lds, u, -1, kpre, wave);
            }
            __syncthreads();
        }
        SEAM();
        if (RUN && PON(8)) for (int rep_ = 0; rep_ < NREP(8); ++rep_) {
            pg8::Gemm g{XO, WXO + (size_t)l * DM * DM, MP, DM, DM}; pg8::StaticOrder S; S.init(MP, DM, G, bx);
            EpiRes E{ZB, ZB, true, STM + (size_t)sb * MP * 32, STS + (size_t)sb * 128 * 128, args.in[13] + l * DM, args.in[14] + l * DM,
                     STM + (size_t)(sb ^ 1) * MP * 32, STS + (size_t)(sb ^ 1) * 128 * 128};
            pg8::gemm_phase(lds, g, S, E, wave);
            skinny_gemm<4>(XO, WXO + (size_t)l * DM * DM, DM, DM, E, lds, bx, G, wave); }
        SEAM(); sb ^= 1;
        if (RUN && PON(10)) for (int rep_ = 0; rep_ < NREP(10); ++rep_) {
            pg8::Gemm g{ZB, WUP + (size_t)l * FF * DM, MP, FF, DM}; pg8::StaticOrder S; S.init(MP, FF, G, bx);
            EpiFold<FRelu2> E{FRelu2{H}, true, STM + (size_t)sb * MP * 32, STS + (size_t)sb * 128 * 128, cvl + 4 * 4096, cvl + 5 * 4096};
            pg8::gemm_phase(lds, g, S, E, wave);
            skinny_gemm<1>(ZB, WUP + (size_t)l * FF * DM, FF, DM, E, lds, bx, G, wave); }
        SEAM();
        if (RUN && PON(11)) for (int rep_ = 0; rep_ < NREP(11); ++rep_) {
            pg8::Gemm g{H, WDN + (size_t)l * DM * FF, MP, DM, FF}; pg8::StaticOrder S; S.init(MP, DM, G, bx);
            EpiRes E{ZB, ZB, true, STM + (size_t)sb * MP * 32, STS + (size_t)sb * 128 * 128, args.in[18] + l * DM, args.in[19] + l * DM,
                     STM + (size_t)(sb ^ 1) * MP * 32, STS + (size_t)(sb ^ 1) * 128 * 128};
            pg8::gemm_phase(lds, g, S, E, wave);
            skinny_gemm<4>(H, WDN + (size_t)l * DM * FF, DM, FF, E, lds, bx, G, wave); }
        SEAM(); sb ^= 1;
    }
    if (RUN && PON(12)) for (int rep_ = 0; rep_ < NREP(12); ++rep_) { OPAQ(); final_ln(ZB, args.in[22] + (DEPTH - 1) * DM, args.in[23] + (DEPTH - 1) * DM, out, gw, NGW, lane); }
    SEAM();
#undef RUN
#undef SEAM
}
constexpr int N_PHASES = 2 + DEPTH * 8;

extern "C" void kernel_launch(void* const* d_in, const int* in_sizes, int n_in, void* d_out, int out_size, void* d_ws, size_t ws_size, hipStream_t stream) {
    static int grid = 0;
    if (grid == 0) {
        if (n_in != 24 || ws_size < WS_END) { fprintf(stderr, "kernel_launch: need 24 inputs and %zu bytes of ws (got %d, %zu)\n", (size_t)WS_END, n_in, ws_size); grid = -1; return; }
        int dev = 0, cus = 0, per_cu = 0;
        hipGetDevice(&dev); hipDeviceGetAttribute(&cus, hipDeviceAttributeMultiprocessorCount, dev);
        if (hipFuncSetAttribute((const void*)mega, hipFuncAttributeMaxDynamicSharedMemorySize, LDS_BYTES) != hipSuccess) { fprintf(stderr, "kernel_launch: hipFuncSetAttribute failed\n"); grid = -1; return; }
        hipOccupancyMaxActiveBlocksPerMultiprocessor(&per_cu, (const void*)mega, NWAVES * 64, LDS_BYTES);
        if (per_cu < 1) { fprintf(stderr, "kernel_launch: occupancy query says %d blocks/CU\n", per_cu); per_cu = 1; }
        (void)hipGetLastError();
        grid = cus * 1;
    }
    if (grid < 0) return;
    if (hipMemsetAsync((char*)d_ws + WS_BAR, 0, WS_BAR_BYTES, stream) != hipSuccess) { fprintf(stderr, "kernel_launch: memset failed\n"); return; }
    Args a{};
    for (int i = 0; i < 24; ++i) a.in[i] = (const float*)d_in[i];
    a.out = (float*)d_out; a.ws = (unsigned char*)d_ws;
#if MK_MULTI
    for (int p = 0; p < N_PHASES; ++p) {
        a.ph_lo = p; a.ph_hi = p + 1;
        hipLaunchKernelGGL(mega, dim3(grid), dim3(NWAVES * 64), LDS_BYTES, stream, a);
    }
#else
    a.ph_lo = 0; a.ph_hi = N_PHASES;
    void* kargs[] = {&a};
    hipError_t e = hipLaunchCooperativeKernel((const void*)mega, dim3(grid), dim3(NWAVES * 64), kargs, LDS_BYTES, stream);
    if (e != hipSuccess) fprintf(stderr, "cooperative launch failed: %s (grid %d)\n", hipGetErrorString(e), grid);
#endif
}
```

```cpp
#include <hip/hip_runtime.h>
#include <hip/hip_cooperative_groups.h>
#include <cstdio>
#include <cstdint>
namespace cg = cooperative_groups;

#ifndef MK_MULTI
#define MK_MULTI 0
#endif

#define LAS __attribute__((address_space(3)))
typedef unsigned short bf16_t;
typedef short bf16x8 __attribute__((ext_vector_type(8)));
typedef short s16x4 __attribute__((ext_vector_type(4)));
typedef float f32x4 __attribute__((ext_vector_type(4)));
typedef unsigned u32x4 __attribute__((ext_vector_type(4)));
typedef unsigned u32x2 __attribute__((ext_vector_type(2)));

constexpr int DM = 1024, SEQ = 2048, NB = 8, DEPTH = 2, DECB = 32, DECS = 4;
constexpr int MP = NB * SEQ;
constexpr int MS = DECB * DECS;
constexpr int MR = MP + MS;
constexpr int MT = 16640;
constexpr int INC = 2816, ATT = 768, FF = 4096, NMEM = 256;
constexpr float LN_EPS = 1e-5f;
constexpr float ALPHA = 1.41421356237309515f;
constexpr float LOG2E = 1.4426950408889634f, LN2 = 0.6931471805599453f;
constexpr float QSCALE = 0.125f * LOG2E;
constexpr float XQSCALE = 0.0625f * LOG2E;

constexpr size_t O0 = 0, O1 = 16777216, O2 = 16908288, O3 = 17956864, O4 = 22151168, O5 = 38928384,
                 O6 = 47316992, O7 = 47448064, O8 = 47579136, O9 = 47710208;

constexpr size_t al256(size_t x) { return (x + 255) & ~(size_t)255; }
constexpr size_t WS_BAR = 0, WS_BAR_BYTES = 16384;
constexpr size_t WS_ROPE = 16384;
constexpr size_t WS_WIN = al256(WS_ROPE + 2052 * 16 * 4);
constexpr size_t WS_WMIX = WS_WIN + (size_t)DEPTH * INC * DM * 2;
constexpr size_t WS_WXQ = WS_WMIX + (size_t)DEPTH * DM * DM * 2;
constexpr size_t WS_WXKV = WS_WXQ + (size_t)DEPTH * DM * DM * 2;
constexpr size_t WS_WXO = WS_WXKV + (size_t)DEPTH * 2 * DM * DM * 2;
constexpr size_t WS_WUP = WS_WXO + (size_t)DEPTH * DM * DM * 2;
constexpr size_t WS_WDN = WS_WUP + (size_t)DEPTH * FF * DM * 2;
constexpr size_t WS_WSP = WS_WDN + (size_t)DEPTH * FF * DM * 2;
constexpr size_t WS_MEMB = WS_WSP + (size_t)DEPTH * 4 * 128 * 128 * 2;
constexpr size_t WS_MKV = WS_MEMB + (size_t)2048 * DM * 2;
constexpr size_t WS_CV = WS_MKV + (size_t)DEPTH * 2048 * 2048 * 2;
constexpr size_t WS_CVP = WS_CV + (size_t)DEPTH * 3 * 2 * 4096 * 4;
constexpr size_t WS_STM = WS_CVP + (size_t)DEPTH * 3 * 16 * 2 * 4096 * 4;
constexpr size_t WS_STS = WS_STM + (size_t)2 * MP * 32 * 4;
constexpr size_t WS_GST = WS_STS + (size_t)2 * 128 * 128 * 4;
constexpr size_t WS_ZB = WS_GST + (size_t)MP * 8 * 4;
constexpr size_t WS_XB = WS_ZB + (size_t)MT * DM * 2;
constexpr size_t WS_Q = WS_XB + (size_t)MT * DM * 2;
constexpr size_t WS_K = WS_Q + (size_t)MT * ATT * 2;
constexpr size_t WS_V = WS_K + (size_t)MT * ATT * 2;
constexpr size_t WS_U = WS_V + (size_t)MT * ATT * 2;
constexpr size_t WS_G = WS_U + (size_t)MT * 256 * 2;
constexpr size_t WS_CAT = WS_G + (size_t)MT * 256 * 2;
constexpr size_t WS_LSE = WS_CAT + (size_t)MT * DM * 2;
constexpr size_t WS_XQ = WS_LSE + (size_t)MT * 16 * 4;
constexpr size_t WS_XO = WS_XQ + (size_t)MT * DM * 2;
constexpr size_t WS_H = WS_XO + (size_t)MT * DM * 2;
constexpr size_t WS_END = WS_H + (size_t)MT * FF * 2;

constexpr int LDS_BYTES = 147456;
constexpr int NWAVES = 8;

__device__ __forceinline__ unsigned f2bf(float f) { unsigned u = __builtin_bit_cast(unsigned, f); return (u + 0x7fffu + ((u >> 16) & 1u)) >> 16; }
typedef float f32x2_t __attribute__((ext_vector_type(2))); typedef __bf16 bf16x2_t __attribute__((ext_vector_type(2)));
__device__ __forceinline__ unsigned pk2(float lo, float hi) { const f32x2_t v = {lo, hi}; const bf16x2_t b = __builtin_convertvector(v, bf16x2_t); return __builtin_bit_cast(unsigned, b); }
__device__ __forceinline__ float bf2f(unsigned short h) { return __builtin_bit_cast(float, (unsigned)h << 16); }
__device__ __forceinline__ float bflo(unsigned u) { return __builtin_bit_cast(float, u << 16); }
__device__ __forceinline__ float bfhi(unsigned u) { return __builtin_bit_cast(float, u & 0xffff0000u); }
__device__ __forceinline__ u32x2 pk4(f32x4 v) { u32x2 r; r.x = pk2(v.x, v.y); r.y = pk2(v.z, v.w); return r; }
__device__ __forceinline__ float wave_sum(float v) {
#pragma unroll
    for (int o = 1; o < 64; o <<= 1) v += __shfl_xor(v, o);
    return v;
}
__device__ __forceinline__ float gelu_tanh(float x) {
    const float t = x * (2.302208198f + 0.1029432397f * x * x);
    const float e = __builtin_amdgcn_exp2f(fminf(t, 80.f));
    return x - x * __builtin_amdgcn_rcpf(1.f + e);
}
__device__ __forceinline__ int lane_id_v() { int l; asm volatile("v_mbcnt_lo_u32_b32 %0, -1, 0\n\tv_mbcnt_hi_u32_b32 %0, -1, %0" : "=v"(l)); return l; }
#define LDS_WAIT() asm volatile("s_waitcnt lgkmcnt(0)" ::: "memory")
#define VM_WAIT() asm volatile("s_waitcnt vmcnt(0)" ::: "memory")
__device__ __forceinline__ s16x4 vtr(const LAS unsigned char* p) {
    return __builtin_bit_cast(s16x4, __builtin_amdgcn_ds_read_tr16_b64_v4i16((LAS s16x4*)p));
}


#define XB_DONE     3520
#define XB_TMO      128
#define XB_XCNT(j)  (256  + 64 * (j))
#define XB_XSUB(j)  (1280 + 64 * (j))
#define XB_XGEN(j)  (2304 + 64 * (j))
#define XB_TOP      3328
#define XB_TOPGEN   3392
#define XCD_BAR_WORDS 3456
#define XB_SPIN_CAP (1u << 22)
__device__ unsigned g_bar[3712];
__device__ __forceinline__ unsigned xb_ld(unsigned* p)              { return __hip_atomic_load(p, __ATOMIC_RELAXED, __HIP_MEMORY_SCOPE_AGENT); }
__device__ __forceinline__ unsigned xb_add(unsigned* p, unsigned v) { return __hip_atomic_fetch_add(p, v, __ATOMIC_RELAXED, __HIP_MEMORY_SCOPE_AGENT); }
__device__ __forceinline__ unsigned xb_xcc_id() { return (unsigned)__builtin_amdgcn_s_getreg((3 << 11) | 20) & 0xFu; }
#define XB_SPIN(cond, bar) do { unsigned _sp = 0; while (cond) { __builtin_amdgcn_s_sleep(1); \
    if ((++_sp & 255u) == 0u) { if (xb_ld(&(bar)[XB_TMO])) break; if (_sp > XB_SPIN_CAP) { atomicAdd(&(bar)[XB_TMO], 1u); break; } } } } while (0)
struct XcdBarrier { unsigned* bar; unsigned x; volatile LAS unsigned* st; };
__device__ __forceinline__ XcdBarrier xcd_barrier_post(unsigned* bar, volatile LAS unsigned* st, int wave) {
    XcdBarrier b; b.bar = bar; b.x = xb_xcc_id(); b.st = st;
    if (wave == 0 && lane_id_v() == 0) (void)xb_add(&bar[XB_XCNT(b.x)], 1u);
    return b;
}
__device__ __forceinline__ void xcd_barrier_complete(unsigned* bar, unsigned x, unsigned& nloc, unsigned& nx) {
    const unsigned G = gridDim.x * gridDim.y * gridDim.z;
    unsigned sum, cnt, mine, sp = 0u;
    for (;;) {
        sum = 0u; cnt = 0u; mine = 0u;
#pragma unroll
        for (unsigned j = 0; j < 16; ++j) { const unsigned c = xb_ld(&bar[XB_XCNT(j)]); sum += c; cnt += (c > 0u) ? 1u : 0u; mine = (j == x) ? c : mine; }
        if (sum == G) break;
        __builtin_amdgcn_s_sleep(1);
        if ((++sp & 255u) == 0u) { if (xb_ld(&bar[XB_TMO])) break; if (sp > XB_SPIN_CAP) { atomicAdd(&bar[XB_TMO], 1u); break; } }
    }
    nloc = mine > 0u ? mine : 1u; nx = cnt > 0u ? cnt : 1u;
}
__device__ __forceinline__ void xcd_barrier(const XcdBarrier& b, int wave) {
    asm volatile("s_waitcnt vmcnt(0)" ::: "memory");
    __syncthreads();
    if (wave == 0 && lane_id_v() == 0) {
        unsigned* bar = b.bar;
        __builtin_amdgcn_s_waitcnt(0);
        unsigned nloc = b.st[0], nx = b.st[1];
        if (nloc == 0u) { xcd_barrier_complete(bar, b.x, nloc, nx); b.st[0] = nloc; b.st[1] = nx; }
        const unsigned old = xb_add(&bar[XB_XSUB(b.x)], 1u);
        const unsigned gen = old / nloc;
        if (old + 1u == (gen + 1u) * nloc) {
            __builtin_amdgcn_fence(__ATOMIC_RELEASE, "agent");
            asm volatile("s_waitcnt vmcnt(0)" ::: "memory");
            const unsigned og = xb_add(&bar[XB_TOP], 1u);
            const unsigned tg = og / nx;
            if (og + 1u == (tg + 1u) * nx) xb_add(&bar[XB_TOPGEN], 1u);
            else XB_SPIN(xb_ld(&bar[XB_TOPGEN]) == tg, bar);
            __builtin_amdgcn_fence(__ATOMIC_ACQUIRE, "agent");
            xb_add(&bar[XB_XGEN(b.x)], 1u);
            asm volatile("s_waitcnt vmcnt(0)" ::: "memory");
        } else {
            XB_SPIN(xb_ld(&bar[XB_XGEN(b.x)]) == gen, bar);
            __builtin_amdgcn_fence(__ATOMIC_ACQUIRE, "agent");
            asm volatile("s_waitcnt vmcnt(0)" ::: "memory");
        }
    }
    __syncthreads();
}

namespace pg8 {
constexpr int BM = 256, BK = 64, HALF = 128, HTB = HALF * BK * 2, NXCD = 8, WGM = 8;
__host__ __device__ __forceinline__ int lds_byte(int r, int c) { const int st = (r >> 4) * 2 + (c >> 5), rr = r & 15, cc = c & 31, ob = rr * 64 + cc * 2; return st * 1024 + (ob ^ (((ob >> 9) & 1) << 5)); }
__host__ __device__ __forceinline__ void stage_rc(int b, int& R, int& C) { const int st = b / 1024, sb = b % 1024, swz = sb ^ (((sb >> 9) & 1) << 5); R = (st >> 1) * 16 + swz / 64; C = (st & 1) * 32 + (swz % 64) / 2; }
struct Unit { int pm, pn; };
struct Gemm { const bf16_t* A; const bf16_t* Bt; int M, N, K; };
struct StaticOrder {
    int nM, nN, nwg, G, c;
    __host__ __device__ void init(int M, int N, int G_, int c_) { nM = M / BM; nN = N / BM; nwg = nM * nN; G = G_; c = c_; }
    __host__ __device__ bool next(int i, Unit& u) const {
        const long L = (long)i * G + c; if (L >= nwg) return false;
        int wgid = (int)L; { const int q = nwg / NXCD, r = nwg % NXCD, xcd = wgid % NXCD, off = wgid / NXCD; wgid = (xcd < r ? xcd * (q + 1) : r * (q + 1) + (xcd - r) * q) + off; }
        const int nig = WGM * nN, gid = wgid / nig, fm = gid * WGM, gsz = (nM - fm) < WGM ? (nM - fm) : WGM;
        u.pm = fm + ((wgid % nig) % gsz); u.pn = (wgid % nig) / gsz; return true;
    }
};

template <class Epi, class Sched>
__device__ __forceinline__ void gemm_phase(LAS unsigned char* lds, const Gemm g, const Sched& S, const Epi& E, int wid) {
    const int lane = lane_id_v(), tid = wid * 64 + lane;
    const int wr = wid >> 2, wc = wid & 3, fr = lane & 15, fq = lane >> 4;
    const int K = g.K, nt = K / BK;
    unsigned voffA[2];
#pragma unroll
    for (int i = 0; i < 2; ++i) { int R, C; stage_rc(tid * 16 + i * 8192, R, C); voffA[i] = (unsigned)(R * K + C) * 2u; }
    const size_t kstep = (size_t)(BK * 2);
    const size_t hstep = (size_t)HALF * K * 2;
    const size_t tstep = 2 * hstep;
    const unsigned ldsw = (unsigned)wid * 1024u;
    const int aoff = lds_byte(wr * 64 + fr, fq * 8), boff = lds_byte(wc * 32 + fr, fq * 8);
#define PG8_SA(b, h) (((b) * 2 + (h)) * HTB)
#define PG8_SB(b, h) ((4 + (b) * 2 + (h)) * HTB)
#define PG8_STAGE(bufoff, gbase) do { _Pragma("unroll") for (int _i = 0; _i < 2; ++_i) \
        __builtin_amdgcn_global_load_lds((const unsigned*)((const char*)(gbase) + voffA[_i]), (LAS unsigned*)(lds + (bufoff) + ldsw + _i * 8192), 16, 0, 0); } while (0)
#define PG8_LDA(dst, b, h) do { _Pragma("unroll") for (int m = 0; m < 4; ++m) _Pragma("unroll") for (int k = 0; k < 2; ++k) dst[m][k] = *(const LAS bf16x8*)(lds + PG8_SA(b, h) + aoff + m * 2048 + k * 1024); } while (0)
#define PG8_LDB(dst, b, h) do { _Pragma("unroll") for (int n = 0; n < 2; ++n) _Pragma("unroll") for (int k = 0; k < 2; ++k) dst[n][k] = *(const LAS bf16x8*)(lds + PG8_SB(b, h) + boff + n * 2048 + k * 1024); } while (0)
#define PG8_MMA(ai, bj, At, Bt) do { __builtin_amdgcn_s_setprio(1); _Pragma("unroll") for (int m = 0; m < 4; ++m) _Pragma("unroll") for (int n = 0; n < 2; ++n) _Pragma("unroll") for (int k = 0; k < 2; ++k) \
        acc[ai][bj][m][n] = __builtin_amdgcn_mfma_f32_16x16x32_bf16(Bt[n][k], At[m][k], acc[ai][bj][m][n], 0, 0, 0); __builtin_amdgcn_s_setprio(0); } while (0)
#define PG8_WAIT_V(n) asm volatile("s_waitcnt vmcnt(" #n ")" ::: "memory")
#define PG8_WAIT_L(n) asm volatile("s_waitcnt lgkmcnt(" #n ")" ::: "memory")
#define PG8_BAR __builtin_amdgcn_s_barrier()
#define PG8_SCHED __builtin_amdgcn_sched_barrier(0)
    Unit cur, nxt; int ui = 0;
    if (!S.next(0, cur)) return;
    f32x4 acc[2][2][4][2];
#pragma unroll
    for (int a = 0; a < 2; ++a)
#pragma unroll
        for (int b = 0; b < 2; ++b)
#pragma unroll
            for (int m = 0; m < 4; ++m)
#pragma unroll
                for (int n = 0; n < 2; ++n) acc[a][b][m][n] = (f32x4){0.f, 0.f, 0.f, 0.f};
    bf16x8 At[4][2], B0[2][2], B1[2][2];
    const char* cA = (const char*)g.A + (size_t)cur.pm * tstep; const char* cB = (const char*)g.Bt + (size_t)cur.pn * tstep;
    PG8_STAGE(PG8_SB(0, 0), cB); PG8_STAGE(PG8_SB(0, 1), cB + hstep); PG8_STAGE(PG8_SA(0, 0), cA); PG8_STAGE(PG8_SA(0, 1), cA + hstep);
    if (wr == 1) PG8_BAR;
    PG8_WAIT_V(2); PG8_BAR;
    PG8_STAGE(PG8_SB(1, 0), cB + kstep); PG8_STAGE(PG8_SA(1, 0), cA + kstep); PG8_STAGE(PG8_SB(1, 1), cB + hstep + kstep);
    PG8_WAIT_V(6); PG8_BAR;
    for (;;) {
        const bool has_next = S.next(ui + 1, nxt);
        const char* nA = has_next ? (const char*)g.A + (size_t)nxt.pm * tstep : cA; const char* nB = has_next ? (const char*)g.Bt + (size_t)nxt.pn * tstep : cB;
        for (int t = 0; t < nt; t += 2) {
            const bool last = (t == nt - 2);
            const char* a1 = cA + (size_t)(t + 1) * kstep;
            const char* a2 = last ? nA : cA + (size_t)(t + 2) * kstep; const char* b2 = last ? nB : cB + (size_t)(t + 2) * kstep;
            const char* a3 = a2 + kstep; const char* b3 = b2 + kstep;
            PG8_LDB(B0, 0, 0); PG8_LDB(B1, 0, 1); PG8_SCHED; PG8_LDA(At, 0, 0); PG8_STAGE(PG8_SA(1, 1), a1 + hstep);
            PG8_WAIT_V(8); PG8_WAIT_L(0); PG8_BAR; PG8_MMA(0, 0, At, B0); PG8_MMA(0, 1, At, B1); PG8_BAR; PG8_SCHED;
            PG8_LDA(At, 0, 1); PG8_STAGE(PG8_SB(0, 0), b2); PG8_STAGE(PG8_SB(0, 1), b2 + hstep); PG8_STAGE(PG8_SA(0, 0), a2);
            PG8_WAIT_V(8); PG8_WAIT_L(0); PG8_BAR; PG8_MMA(1, 0, At, B0); PG8_MMA(1, 1, At, B1); PG8_BAR; PG8_SCHED;
            PG8_LDB(B0, 1, 0); PG8_LDB(B1, 1, 1); PG8_SCHED; PG8_LDA(At, 1, 0); PG8_STAGE(PG8_SA(0, 1), a2 + hstep);
            PG8_WAIT_V(8); PG8_WAIT_L(0); PG8_BAR; PG8_MMA(0, 0, At, B0); PG8_MMA(0, 1, At, B1); PG8_BAR; PG8_SCHED;
            PG8_LDA(At, 1, 1); PG8_STAGE(PG8_SB(1, 0), b3); PG8_STAGE(PG8_SB(1, 1), b3 + hstep); PG8_STAGE(PG8_SA(1, 0), a3);
            PG8_WAIT_V(8); PG8_WAIT_L(0); PG8_BAR; PG8_MMA(1, 0, At, B0); PG8_MMA(1, 1, At, B1); PG8_BAR; PG8_SCHED;
        }
        if (wr == 0) PG8_BAR;
        E(acc, cur, wr, wc, fr, fq);
        if (!has_next) break;
#pragma unroll
        for (int a = 0; a < 2; ++a)
#pragma unroll
            for (int b = 0; b < 2; ++b)
#pragma unroll
                for (int m = 0; m < 4; ++m)
#pragma unroll
                    for (int n = 0; n < 2; ++n) acc[a][b][m][n] = (f32x4){0.f, 0.f, 0.f, 0.f};
        cur = nxt; cA = nA; cB = nB; ++ui;
        if (wr == 1) PG8_BAR;
    }
    PG8_WAIT_V(0);
    PG8_BAR;
#undef PG8_SA
#undef PG8_SB
#undef PG8_STAGE
#undef PG8_LDA
#undef PG8_LDB
#undef PG8_MMA
#undef PG8_WAIT_V
#undef PG8_WAIT_L
#undef PG8_BAR
#undef PG8_SCHED
}

template <class F> struct EpiWrap {
    F f;
    __device__ __forceinline__ void operator()(const f32x4 (&acc)[2][2][4][2], const Unit& u, int wr, int wc, int fr, int fq) const {
#pragma unroll
        for (int bj = 0; bj < 2; ++bj)
#pragma unroll
            for (int n = 0; n < 2; ++n) {
                const int col = u.pn * BM + bj * HALF + wc * 32 + n * 16 + fq * 4;
#pragma unroll
                for (int ai = 0; ai < 2; ++ai)
#pragma unroll
                    for (int m = 0; m < 4; ++m) f(u.pm * BM + ai * HALF + wr * 64 + m * 16 + fr, col, acc[ai][bj][m][n], fq);
            }
    }
};
}

struct FMkv {
    float* out; bf16_t* mkv; int l;
    __device__ __forceinline__ void operator()(int row, int col, f32x4 v, int) const {
        const int c = col;
        *(f32x4*)(out + O5 + ((size_t)l * 2048 + row) * 2048 + c) = v;
        *(u32x2*)(mkv + ((size_t)l * 2048 + row) * 2048 + c) = pk4(v);
    }
};
struct FProj {
    bf16_t *Qb, *Kb, *Vb, *Ub, *Gb; const float* rope; float* out; int l; float* gst;
    __device__ __forceinline__ void kvout(int row, int c, int kv, f32x4 v) const {
        const int head = c >> 6, g = head >> 2, hs = head & 3, dd = c & 63;
        if (row < MP) {
            const int b = row >> 11, t = row & 2047;
            const int win = g == 0 ? 128 : (g == 1 ? 512 : 2048);
            const int tw = t - (2048 - win);
            if (tw >= 0) {
                const size_t base = g == 0 ? O2 : (g == 1 ? O3 : O4);
                *(f32x4*)(out + base + ((((size_t)l * NB + b) * win + tw) * 2 + kv) * 256 + hs * 64 + dd) = v;
            }
        } else if (row < MR) {
            const int r = row - MP;
            const size_t base = g == 0 ? O6 : (g == 1 ? O7 : O8);
            *(f32x4*)(out + base + (((size_t)l * MS + r) * 2 + kv) * 256 + hs * 64 + dd) = v;
        }
    }
    __device__ __forceinline__ void operator()(int row, int col, f32x4 v, int fq, float& s1, float& s2) const {
        if (col < 1536) {
            const bool isk = col >= 768; const int c = isk ? col - 768 : col;
            if ((c & 48) == 0) {
                const int pos = row < MP ? (row & 2047) : 2048 + ((row - MP) & 3);
                const float* rt = rope + pos * 16 + (fq & 1) * 4;
                const f32x4 cs = *(const f32x4*)rt, sn = *(const f32x4*)(rt + 8);
                f32x4 o; o.x = __shfl_xor(v.x, 32); o.y = __shfl_xor(v.y, 32); o.z = __shfl_xor(v.z, 32); o.w = __shfl_xor(v.w, 32);
                if (fq < 2) v = v * cs - o * sn; else v = v * cs + o * sn;
            }
            if (!isk) { *(u32x2*)(Qb + (size_t)row * ATT + c) = pk4(v * QSCALE); }
            else { *(u32x2*)(Kb + (size_t)row * ATT + c) = pk4(v); kvout(row, c, 0, v); }
        } else if (col < 2304) {
            const int c = col - 1536;
            *(u32x2*)(Vb + (size_t)row * ATT + c) = pk4(v); kvout(row, c, 1, v);
        } else {
            f32x4 gl; gl.x = gelu_tanh(v.x); gl.y = gelu_tanh(v.y); gl.z = gelu_tanh(v.z); gl.w = gelu_tanh(v.w);
            if (col < 2560) *(u32x2*)(Ub + (size_t)row * 256 + (col - 2304)) = pk4(gl);
            else { const u32x2 pg = pk4(gl); *(u32x2*)(Gb + (size_t)row * 256 + (col - 2560)) = pg;
                const float z0 = bflo(pg.x), z1 = bfhi(pg.x), z2 = bflo(pg.y), z3 = bfhi(pg.y);
                s1 += (z0 + z1) + (z2 + z3); s2 += (z0 * z0 + z1 * z1) + (z2 * z2 + z3 * z3); }
        }
    }
    __device__ __forceinline__ void finish(const pg8::Unit& u, int wr, int wc, int fr, int fq, float (&s1)[2][4], float (&s2)[2][4]) const {
        if (u.pn != 10) return;
#pragma unroll
        for (int ai = 0; ai < 2; ++ai)
#pragma unroll
            for (int m = 0; m < 4; ++m) {
                float a = s1[ai][m], b = s2[ai][m];
                a += __shfl_xor(a, 16); b += __shfl_xor(b, 16); a += __shfl_xor(a, 32); b += __shfl_xor(b, 32);
                if (fq == 0) { float* p = gst + (size_t)(u.pm * 256 + ai * 128 + wr * 64 + m * 16 + fr) * 8 + wc * 2; p[0] = a; p[1] = b; }
            }
    }
};
__device__ __forceinline__ void stats_main(const float* stm, int row, int fq, float& mu, float& rs) {
    const f32x4* p = (const f32x4*)(stm + (size_t)row * 32 + fq * 8);
    const f32x4 a = p[0], b = p[1];
    float s1 = (a.x + a.z) + (b.x + b.z), s2 = (a.y + a.w) + (b.y + b.w);
    s1 += __shfl_xor(s1, 16); s2 += __shfl_xor(s2, 16); s1 += __shfl_xor(s1, 32); s2 += __shfl_xor(s2, 32);
    mu = s1 * (1.f / DM); rs = 1.f / sqrtf(fmaxf(s2 * (1.f / DM) - mu * mu, 0.f) + LN_EPS);
}
__device__ __forceinline__ void stats_sk(const float* sts, int row, int fq, float& mu, float& rs) {
    const f32x4* p = (const f32x4*)(sts + (size_t)(row - MP) * 128 + fq * 32);
    float s1 = 0.f, s2 = 0.f;
#pragma unroll
    for (int i = 0; i < 8; ++i) { const f32x4 a = p[i]; s1 += a.x + a.z; s2 += a.y + a.w; }
    s1 += __shfl_xor(s1, 16); s2 += __shfl_xor(s2, 16); s1 += __shfl_xor(s1, 32); s2 += __shfl_xor(s2, 32);
    mu = s1 * (1.f / DM); rs = 1.f / sqrtf(fmaxf(s2 * (1.f / DM) - mu * mu, 0.f) + LN_EPS);
}
template <class F> struct EpiFold {
    F f; bool fold; const float* stm; const float* sts; const float* c1; const float* c2;
    __device__ __forceinline__ void operator()(const f32x4 (&acc)[2][2][4][2], const pg8::Unit& u, int wr, int wc, int fr, int fq) const {
        float mu[2][4], rs[2][4], ps1[2][4], ps2[2][4];
#pragma unroll
        for (int ai = 0; ai < 2; ++ai)
#pragma unroll
            for (int m = 0; m < 4; ++m) { ps1[ai][m] = 0.f; ps2[ai][m] = 0.f; mu[ai][m] = 0.f; rs[ai][m] = 1.f; if (fold) stats_main(stm, u.pm * 256 + ai * 128 + wr * 64 + m * 16 + fr, fq, mu[ai][m], rs[ai][m]); }
#pragma unroll
        for (int bj = 0; bj < 2; ++bj)
#pragma unroll
            for (int n = 0; n < 2; ++n) {
                const int col = u.pn * 256 + bj * 128 + wc * 32 + n * 16 + fq * 4;
                f32x4 c1v = (f32x4){0.f, 0.f, 0.f, 0.f}, c2v = c1v;
                if (fold) { c1v = *(const f32x4*)(c1 + col); c2v = *(const f32x4*)(c2 + col); }
#pragma unroll
                for (int ai = 0; ai < 2; ++ai)
#pragma unroll
                    for (int m = 0; m < 4; ++m) {
                        f32x4 v = acc[ai][bj][m][n];
                        if (fold) v = (v - c1v * mu[ai][m]) * rs[ai][m] + c2v;
                        f(u.pm * 256 + ai * 128 + wr * 64 + m * 16 + fr, col, v, fq, ps1[ai][m], ps2[ai][m]);
                    }
            }
        f.finish(u, wr, wc, fr, fq, ps1, ps2);
    }
    __device__ __forceinline__ void sk(int row, int col, f32x4 v, int fq) const {
        if (fold) { float mu, rs; stats_sk(sts, row, fq, mu, rs); const f32x4 c1v = *(const f32x4*)(c1 + col), c2v = *(const f32x4*)(c2 + col); v = (v - c1v * mu) * rs + c2v; }
        float d1 = 0.f, d2 = 0.f; f(row, col, v, fq, d1, d2);
    }
};
struct EpiRes {
    const bf16_t* src; bf16_t* dst; bool ln; const float* stm_p; const float* sts_p; const float* g; const float* b; float* stm_n; float* sts_n;
    __device__ __forceinline__ void operator()(const f32x4 (&acc)[2][2][4][2], const pg8::Unit& u, int wr, int wc, int fr, int fq) const {
#pragma unroll
        for (int ai = 0; ai < 2; ++ai)
#pragma unroll
            for (int m = 0; m < 4; ++m) {
                const int row = u.pm * 256 + ai * 128 + wr * 64 + m * 16 + fr;
                float mu = 0.f, rs = 1.f; if (ln) stats_main(stm_p, row, fq, mu, rs);
                float s1 = 0.f, s2 = 0.f;
#pragma unroll
                for (int bj = 0; bj < 2; ++bj)
#pragma unroll
                    for (int n = 0; n < 2; ++n) {
                        const int col = u.pn * 256 + bj * 128 + wc * 32 + n * 16 + fq * 4;
                        const u32x2 raw = *(const u32x2*)(src + (size_t)row * DM + col);
                        f32x4 x = (f32x4){bflo(raw.x), bfhi(raw.x), bflo(raw.y), bfhi(raw.y)};
                        if (ln) x = (x - mu) * rs * *(const f32x4*)(g + col) + *(const f32x4*)(b + col);
                        const u32x2 pz = pk4(x * ALPHA + acc[ai][bj][m][n]);
                        *(u32x2*)(dst + (size_t)row * DM + col) = pz;
                        const float z0 = bflo(pz.x), z1 = bfhi(pz.x), z2 = bflo(pz.y), z3 = bfhi(pz.y);
                        s1 += (z0 + z1) + (z2 + z3); s2 += (z0 * z0 + z1 * z1) + (z2 * z2 + z3 * z3);
                    }
                s1 += __shfl_xor(s1, 16); s2 += __shfl_xor(s2, 16); s1 += __shfl_xor(s1, 32); s2 += __shfl_xor(s2, 32);
                if (fq == 0) { float* p = stm_n + (size_t)row * 32 + (u.pn * 4 + wc) * 2; p[0] = s1; p[1] = s2; }
            }
    }
    __device__ __forceinline__ void sk(int row, int col, f32x4 v, int fq) const {
        float mu = 0.f, rs = 1.f; if (ln) stats_sk(sts_p, row, fq, mu, rs);
        const u32x2 raw = *(const u32x2*)(src + (size_t)row * DM + col);
        f32x4 x = (f32x4){bflo(raw.x), bfhi(raw.x), bflo(raw.y), bfhi(raw.y)};
        if (ln) x = (x - mu) * rs * *(const f32x4*)(g + col) + *(const f32x4*)(b + col);
        const u32x2 pz = pk4(x * ALPHA + v);
        *(u32x2*)(dst + (size_t)row * DM + col) = pz;
        const float z0 = bflo(pz.x), z1 = bfhi(pz.x), z2 = bflo(pz.y), z3 = bfhi(pz.y);
        float s1 = (z0 + z1) + (z2 + z3), s2 = (z0 * z0 + z1 * z1) + (z2 * z2 + z3 * z3);
        s1 += __shfl_xor(s1, 16); s2 += __shfl_xor(s2, 16); s1 += __shfl_xor(s1, 32); s2 += __shfl_xor(s2, 32);
        if (fq == 0) { float* p = sts_n + (size_t)(row - MP) * 128 + (col >> 4) * 2; p[0] = s1; p[1] = s2; }
    }
};
struct FScaleBf {
    bf16_t* O; int ldc; float s;
    __device__ __forceinline__ void operator()(int row, int col, f32x4 v, int, float&, float&) const { *(u32x2*)(O + (size_t)row * ldc + col) = pk4(v * s); }
    __device__ __forceinline__ void finish(const pg8::Unit&, int, int, int, int, float (&)[2][4], float (&)[2][4]) const {}
};
struct FRelu2 {
    bf16_t* O;
    __device__ __forceinline__ void finish(const pg8::Unit&, int, int, int, int, float (&)[2][4], float (&)[2][4]) const {}
    __device__ __forceinline__ void operator()(int row, int col, f32x4 v, int, float&, float&) const {
        f32x4 r; r.x = fmaxf(v.x, 0.f); r.y = fmaxf(v.y, 0.f); r.z = fmaxf(v.z, 0.f); r.w = fmaxf(v.w, 0.f);
        *(u32x2*)(O + (size_t)row * FF + col) = pk4(r * r);
    }
};

struct TDesc { const float* W; bf16_t* WT; const float* gsc; const float* bsc; float* cvp; int K, N, item; };
__device__ __forceinline__ void p0_load(const TDesc& d, float (&wv)[32], int lane) {
    const int nblk = d.N / 32, kb = d.item / nblk, nb = d.item % nblk, k0 = 64 * kb, n0 = 32 * nb;
#pragma unroll
    for (int i = 0; i < 32; ++i) wv[i] = d.W[(size_t)(k0 + 2 * i + (lane >> 5)) * d.N + n0 + (lane & 31)];
}
__device__ __forceinline__ void p0_finish(const TDesc& d, float (&wv)[32], LAS float* scr, int lane) {
    const int nblk = d.N / 32, kb = d.item / nblk, nb = d.item % nblk, k0 = 64 * kb, n0 = 32 * nb, K = d.K;
    if (d.gsc) {
        float c1 = 0.f, c2 = 0.f;
#pragma unroll
        for (int i = 0; i < 32; ++i) { const int k = k0 + 2 * i + (lane >> 5); c2 += d.bsc[k] * wv[i]; wv[i] *= d.gsc[k]; c1 += bf2f((unsigned short)f2bf(wv[i])); }
        c1 += __shfl_xor(c1, 32); c2 += __shfl_xor(c2, 32);
        if (lane < 32) { float* p = d.cvp + (size_t)kb * 2 * 4096 + n0 + lane; p[0] = c1; p[4096] = c2; }
    }
#pragma unroll
    for (int i = 0; i < 32; ++i) scr[(2 * i + (lane >> 5)) * 33 + (lane & 31)] = wv[i];
    LDS_WAIT(); asm volatile("" ::: "memory");
    const int c = lane & 7;
#pragma unroll
    for (int j = 0; j < 4; ++j) { const int n = (lane >> 3) + 8 * j; const LAS float* sp = scr + (8 * c) * 33 + n;
        u32x4 o; o.x = pk2(sp[0 * 33], sp[1 * 33]); o.y = pk2(sp[2 * 33], sp[3 * 33]); o.z = pk2(sp[4 * 33], sp[5 * 33]); o.w = pk2(sp[6 * 33], sp[7 * 33]);
        *(u32x4*)(d.WT + (size_t)(n0 + n) * K + k0 + 8 * c) = o; }
    LDS_WAIT(); asm volatile("" ::: "memory");
}

struct Args { const float* in[24]; float* out; unsigned char* ws; int ph_lo, ph_hi; };

__device__ __forceinline__ void final_ln(const bf16_t* ZB, const float* gam, const float* bet, float* yout, int gw, int NGW, int lane) {
    f32x4 gv[4], bv[4];
#pragma unroll
    for (int j = 0; j < 4; ++j) { gv[j] = *(const f32x4*)(gam + 4 * lane + 256 * j); bv[j] = *(const f32x4*)(bet + 4 * lane + 256 * j); }
    for (int row = gw; row < MR; row += NGW) {
        const u32x2* zr = (const u32x2*)(ZB + (size_t)row * DM) + lane;
        f32x4 v[4]; float s = 0.f;
#pragma unroll
        for (int j = 0; j < 4; ++j) { const u32x2 raw = zr[64 * j]; v[j] = (f32x4){bflo(raw.x), bfhi(raw.x), bflo(raw.y), bfhi(raw.y)}; s += (v[j].x + v[j].y) + (v[j].z + v[j].w); }
        const float mean = wave_sum(s) * (1.f / DM); float s2 = 0.f;
#pragma unroll
        for (int j = 0; j < 4; ++j) { v[j] = v[j] - mean; s2 += (v[j].x * v[j].x + v[j].y * v[j].y) + (v[j].z * v[j].z + v[j].w * v[j].w); }
        const float rstd = 1.f / sqrtf(wave_sum(s2) * (1.f / DM) + LN_EPS);
        f32x4* o = (f32x4*)(yout + (size_t)row * DM) + lane;
#pragma unroll
        for (int j = 0; j < 4; ++j) o[64 * j] = v[j] * rstd * gv[j] + bv[j];
    }
}

template <bool SAMPLE>
__device__ __forceinline__ void attn_tile(const bf16_t* Qb, const bf16_t* Kb, const bf16_t* Vb, const float* c0, const float* c1, const float* c2, int l,
                                          LAS unsigned char* orow, LAS float* lsep, LAS unsigned char* vl, int b, int h, int rq, int sb, int lane) {
    const int fr = lane & 15, fq = lane >> 4;
    int s0 = 0, r = 0, qi = 0, kt0 = 0;
    const int g = h >> 2, hs = h & 3, dsh = 2 * g;
    const int npre = g == 0 ? 128 : (g == 1 ? 512 : 2048);
    size_t qrow;
    if (SAMPLE) { qi = rq; qrow = (size_t)MP + b * 4 + qi; }
    else { r = rq; s0 = sb * 16; kt0 = sb >= 8 ? 0 : 8 - sb; qrow = (size_t)b * SEQ + (((s0 + fr) << dsh) + r); }
    const float* cbase = SAMPLE ? (g == 0 ? c0 : (g == 1 ? c1 : c2)) + (size_t)(l * DECB + b) * npre * 512 : nullptr;
    const bf16_t* qp = Qb + qrow * ATT + h * 64 + fq * 8;
    const bf16x8 q0 = *(const bf16x8*)qp, q1 = *(const bf16x8*)(qp + 32);
    u32x4 vr[5][4];
#pragma unroll
    for (int kk = 0; kk < 5; ++kk) {
#pragma unroll
        for (int it = 0; it < 4; ++it) vr[kk][it] = (u32x4){0u, 0u, 0u, 0u};
        if (2 * kk + 1 >= kt0) {
#pragma unroll
            for (int it = 0; it < 4; ++it) {
                const int rl = (lane >> 3) + 8 * it, ch = lane & 7;
                u32x4 w;
                if (SAMPLE) {
                    int j = 32 * kk + rl; j = j > 128 ? 128 : j;
                    const int rr = npre + qi - (j << dsh);
                    if (rr >= npre) w = *(const u32x4*)(Vb + ((size_t)MP + b * 4 + (rr - npre)) * ATT + h * 64 + ch * 8);
                    else { const float* vp = cbase + (size_t)rr * 512 + 256 + hs * 64 + ch * 8; const f32x4 a0 = __builtin_nontemporal_load((const f32x4*)vp), a1 = __builtin_nontemporal_load((const f32x4*)(vp + 4));
                        w.x = pk2(a0.x, a0.y); w.y = pk2(a0.z, a0.w); w.z = pk2(a1.x, a1.y); w.w = pk2(a1.z, a1.w); }
                } else {
                    int sk = s0 - 128 + 32 * kk + rl; sk = sk < 0 ? 0 : sk; sk = sk > s0 + 15 ? s0 + 15 : sk;
                    w = *(const u32x4*)(Vb + ((size_t)b * SEQ + ((sk << dsh) + r)) * ATT + h * 64 + ch * 8);
                }
                vr[kk][it] = w;
            }
        }
    }
    f32x4 S[9];
#pragma unroll
    for (int kt = 0; kt < 9; ++kt) {
        S[kt] = (f32x4){-1e30f, -1e30f, -1e30f, -1e30f};
        if (kt >= kt0) {
            bf16x8 k0, k1;
            if (SAMPLE) {
                int j = 16 * kt + fr; j = j > 128 ? 128 : j;
                const int rr = npre + qi - (j << dsh);
                if (rr >= npre) { const bf16_t* kp = Kb + ((size_t)MP + b * 4 + (rr - npre)) * ATT + h * 64 + fq * 8; k0 = *(const bf16x8*)kp; k1 = *(const bf16x8*)(kp + 32); }
                else { const float* kp = cbase + (size_t)rr * 512 + hs * 64 + fq * 8;
                    const f32x4 a0 = __builtin_nontemporal_load((const f32x4*)kp), a1 = __builtin_nontemporal_load((const f32x4*)(kp + 4)), a2 = __builtin_nontemporal_load((const f32x4*)(kp + 32)), a3 = __builtin_nontemporal_load((const f32x4*)(kp + 36));
                    u32x4 w0, w1; w0.x = pk2(a0.x, a0.y); w0.y = pk2(a0.z, a0.w); w0.z = pk2(a1.x, a1.y); w0.w = pk2(a1.z, a1.w);
                    w1.x = pk2(a2.x, a2.y); w1.y = pk2(a2.z, a2.w); w1.z = pk2(a3.x, a3.y); w1.w = pk2(a3.z, a3.w);
                    k0 = __builtin_bit_cast(bf16x8, w0); k1 = __builtin_bit_cast(bf16x8, w1); }
            } else {
                const int sk = s0 - 128 + 16 * kt + fr;
                const bf16_t* kp = Kb + ((size_t)b * SEQ + ((sk << dsh) + r)) * ATT + h * 64 + fq * 8;
                k0 = *(const bf16x8*)kp; k1 = *(const bf16x8*)(kp + 32);
            }
            f32x4 a = (f32x4){0.f, 0.f, 0.f, 0.f};
            a = __builtin_amdgcn_mfma_f32_16x16x32_bf16(k0, q0, a, 0, 0, 0);
            a = __builtin_amdgcn_mfma_f32_16x16x32_bf16(k1, q1, a, 0, 0, 0);
            S[kt] = a;
        }
    }
    if (SAMPLE) {
#pragma unroll
        for (int j = 0; j < 4; ++j) if (4 * fq + j > 0) S[8][j] = -1e30f;
    } else {
#pragma unroll
        for (int j = 0; j < 4; ++j) { if (4 * fq + j < fr) S[0][j] = -1e30f; if (4 * fq + j > fr) S[8][j] = -1e30f; }
    }
    float m = -1e30f;
#pragma unroll
    for (int kt = 0; kt < 9; ++kt) m = fmaxf(m, fmaxf(fmaxf(S[kt].x, S[kt].y), fmaxf(S[kt].z, S[kt].w)));
    m = fmaxf(m, __shfl_xor(m, 16)); m = fmaxf(m, __shfl_xor(m, 32));
    float den = 0.f;
#pragma unroll
    for (int kt = 0; kt < 9; ++kt) { S[kt].x = __builtin_amdgcn_exp2f(S[kt].x - m); S[kt].y = __builtin_amdgcn_exp2f(S[kt].y - m); S[kt].z = __builtin_amdgcn_exp2f(S[kt].z - m); S[kt].w = __builtin_amdgcn_exp2f(S[kt].w - m); den += (S[kt].x + S[kt].y) + (S[kt].z + S[kt].w); }
    den += __shfl_xor(den, 16); den += __shfl_xor(den, 32);
    f32x4 O[4];
#pragma unroll
    for (int n = 0; n < 4; ++n) O[n] = (f32x4){0.f, 0.f, 0.f, 0.f};
    const LAS unsigned char* trp = vl + (4 * fq + (fr >> 2)) * 160 + (lane & 3) * 8;
#pragma unroll
    for (int kk = 0; kk < 5; ++kk) {
        if (2 * kk + 1 >= kt0) {
#pragma unroll
            for (int it = 0; it < 4; ++it) *(LAS u32x4*)(vl + ((lane >> 3) + 8 * it) * 160 + (lane & 7) * 16) = vr[kk][it];
            LDS_WAIT();
            u32x4 pw; pw.x = pk2(S[2 * kk].x, S[2 * kk].y); pw.y = pk2(S[2 * kk].z, S[2 * kk].w);
            if (kk < 4) { pw.z = pk2(S[(2 * kk + 1) % 9].x, S[(2 * kk + 1) % 9].y); pw.w = pk2(S[(2 * kk + 1) % 9].z, S[(2 * kk + 1) % 9].w); } else { pw.z = 0u; pw.w = 0u; }
            const bf16x8 pb = __builtin_bit_cast(bf16x8, pw);
#pragma unroll
            for (int n = 0; n < 4; ++n) {
                const s16x4 lo = vtr(trp + n * 32), hi = vtr(trp + 16 * 160 + n * 32);
                bf16x8 va; va[0] = lo[0]; va[1] = lo[1]; va[2] = lo[2]; va[3] = lo[3]; va[4] = hi[0]; va[5] = hi[1]; va[6] = hi[2]; va[7] = hi[3];
                O[n] = __builtin_amdgcn_mfma_f32_16x16x32_bf16(va, pb, O[n], 0, 0, 0);
            }
            LDS_WAIT();
        }
    }
    const float inv = __builtin_amdgcn_rcpf(den);
    if (!SAMPLE || fr == 0) {
#pragma unroll
        for (int n = 0; n < 4; ++n) *(LAS u32x2*)(orow + 32 * n + 8 * fq) = pk4(O[n] * inv);
        if (fq == 0) *lsep = m * LN2 + __logf(den);
    }
}

#define WG_BAR() do { asm volatile("s_waitcnt lgkmcnt(0)" ::: "memory"); __builtin_amdgcn_s_barrier(); asm volatile("" ::: "memory"); } while (0)
constexpr int XA_BUF = 128 * 544;
template <bool SAMPLE>
__device__ __forceinline__ void xa_load(u32x4 (&r)[8], const bf16_t* MKVl, const float* cmem, int b, int h, int kv, int half, int tid) {
#pragma unroll
    for (int ps = 0; ps < 8; ++ps) {
        const int row = half * 128 + ps * 16 + (tid >> 5), ch = tid & 31;
        if (SAMPLE) { const float* p = cmem + ((size_t)(b * 256 + row) * 2 + kv) * 1024 + h * 256 + ch * 8; const f32x4 a0 = __builtin_nontemporal_load((const f32x4*)p), a1 = __builtin_nontemporal_load((const f32x4*)(p + 4));
            r[ps].x = pk2(a0.x, a0.y); r[ps].y = pk2(a0.z, a0.w); r[ps].z = pk2(a1.x, a1.y); r[ps].w = pk2(a1.z, a1.w); }
        else r[ps] = *(const u32x4*)(MKVl + (size_t)(b * 256 + row) * 2048 + kv * 1024 + h * 256 + ch * 8);
    }
}
__device__ __forceinline__ void xa_load_any(u32x4 (&r)[8], const bf16_t* MKVl, const float* cmem, int u, int tid) {
    if (u < DECB * 4) xa_load<true>(r, MKVl, cmem, u >> 2, u & 3, 0, 0, tid);
    else { const int v = u - DECB * 4; xa_load<false>(r, MKVl, cmem, v >> 6, (v >> 4) & 3, 0, 0, tid); }
}
__device__ __forceinline__ void xa_store(const u32x4 (&r)[8], LAS unsigned char* buf, int stride, int tid) {
#pragma unroll
    for (int ps = 0; ps < 8; ++ps) *(LAS u32x4*)(buf + (ps * 16 + (tid >> 5)) * stride + (tid & 31) * 16) = r[ps];
}
__device__ __forceinline__ void xa_s_half(f32x4* S8, const bf16x8 (&qf)[8], const LAS unsigned char* buf, int fr, int fq) {
    bf16x8 kf[2][8];
    const LAS unsigned char* kbase = buf + fr * 528 + fq * 16;
#pragma unroll
    for (int ks = 0; ks < 8; ++ks) kf[0][ks] = *(const LAS bf16x8*)(kbase + ks * 64);
#pragma unroll
    for (int kt = 0; kt < 8; ++kt) {
        if (kt + 1 < 8) {
#pragma unroll
            for (int ks = 0; ks < 8; ++ks) kf[(kt + 1) & 1][ks] = *(const LAS bf16x8*)(kbase + (kt + 1) * 16 * 528 + ks * 64);
        }
        f32x4 a = (f32x4){0.f, 0.f, 0.f, 0.f};
#pragma unroll
        for (int ks = 0; ks < 8; ++ks) a = __builtin_amdgcn_mfma_f32_16x16x32_bf16(kf[kt & 1][ks], qf[ks], a, 0, 0, 0);
        S8[kt] = a;
        __builtin_amdgcn_sched_barrier(0);
    }
}
template <bool SAMPLE>
__device__ __forceinline__ void xattn_unit(const bf16_t* XQ, const bf16_t* MKVl, const float* cmem, bf16_t* XO, LAS unsigned char* lds, int u, int next, u32x4 (&kpre)[8], int wave) {
    const int lane = lane_id_v(), tid = wave * 64 + lane, fr = lane & 15, fq = lane >> 4;
    int b, h; size_t qrow;
    if (SAMPLE) { b = u >> 2; h = u & 3; qrow = (size_t)MP + b * 4 + (fr & 3); }
    else { const int v = u - DECB * 4; b = v >> 6; h = (v >> 4) & 3; qrow = (size_t)b * SEQ + (v & 15) * 128 + wave * 16 + fr; }
    LAS unsigned char* bufA = lds; LAS unsigned char* bufB = lds + XA_BUF;
    bf16x8 qf[8];
    { const bf16_t* qp = XQ + qrow * DM + h * 256 + fq * 8;
#pragma unroll
      for (int ks = 0; ks < 8; ++ks) qf[ks] = *(const bf16x8*)(qp + 32 * ks); }
    u32x4 r[8];
    xa_load<SAMPLE>(kpre, MKVl, cmem, b, h, 0, 0, tid);
    xa_load<SAMPLE>(r, MKVl, cmem, b, h, 0, 1, tid);
    WG_BAR();
    xa_store(kpre, bufA, 528, tid);
    xa_load<SAMPLE>(kpre, MKVl, cmem, b, h, 1, 0, tid);
    WG_BAR();
    f32x4 S[16];
    xa_s_half(S, qf, bufA, fr, fq);
    xa_store(r, bufB, 528, tid);
    xa_load<SAMPLE>(r, MKVl, cmem, b, h, 1, 1, tid);
    WG_BAR();
    xa_s_half(S + 8, qf, bufB, fr, fq);
    float m = -1e30f;
#pragma unroll
    for (int kt = 0; kt < 16; ++kt) m = fmaxf(m, fmaxf(fmaxf(S[kt].x, S[kt].y), fmaxf(S[kt].z, S[kt].w)));
    m = fmaxf(m, __shfl_xor(m, 16)); m = fmaxf(m, __shfl_xor(m, 32));
    float den = 0.f;
#pragma unroll
    for (int kt = 0; kt < 16; ++kt) { S[kt].x = __builtin_amdgcn_exp2f(S[kt].x - m); S[kt].y = __builtin_amdgcn_exp2f(S[kt].y - m); S[kt].z = __builtin_amdgcn_exp2f(S[kt].z - m); S[kt].w = __builtin_amdgcn_exp2f(S[kt].w - m); den += (S[kt].x + S[kt].y) + (S[kt].z + S[kt].w); }
    den += __shfl_xor(den, 16); den += __shfl_xor(den, 32);
    u32x4 P[8];
#pragma unroll
    for (int kk = 0; kk < 8; ++kk) { P[kk].x = pk2(S[2 * kk].x, S[2 * kk].y); P[kk].y = pk2(S[2 * kk].z, S[2 * kk].w); P[kk].z = pk2(S[2 * kk + 1].x, S[2 * kk + 1].y); P[kk].w = pk2(S[2 * kk + 1].z, S[2 * kk + 1].w); }
    WG_BAR();
    xa_store(kpre, bufA, 544, tid);
    WG_BAR();
    const float inv = 1.f / den;
    constexpr int NO = SAMPLE ? 2 : 16;
    f32x4 O[NO];
#pragma unroll
    for (int n = 0; n < NO; ++n) O[n] = (f32x4){0.f, 0.f, 0.f, 0.f};
    const int trofs = (4 * fq + (fr >> 2)) * 544 + (lane & 3) * 8 + (SAMPLE ? 2 * wave * 32 : 0);
#pragma unroll 1
    for (int hf = 0; hf < 2; ++hf) {
        if (hf == 1) {
            xa_store(r, bufB, 544, tid);
            WG_BAR();
        }
        const LAS unsigned char* trp = (hf ? bufB : bufA) + trofs;
#pragma unroll 1
        for (int kk = 0; kk < 4; ++kk) {
            const int kq = hf * 4 + kk;
            u32x4 pw = P[0];
#pragma unroll
            for (int q = 1; q < 8; ++q) if (kq == q) pw = P[q];
            const bf16x8 pb = __builtin_bit_cast(bf16x8, pw);
#pragma unroll
            for (int n = 0; n < NO; ++n) {
                const s16x4 lo = vtr(trp + kk * 32 * 544 + n * 32), hi = vtr(trp + kk * 32 * 544 + 16 * 544 + n * 32);
                bf16x8 va; va[0] = lo[0]; va[1] = lo[1]; va[2] = lo[2]; va[3] = lo[3]; va[4] = hi[0]; va[5] = hi[1]; va[6] = hi[2]; va[7] = hi[3];
                O[n] = __builtin_amdgcn_mfma_f32_16x16x32_bf16(va, pb, O[n], 0, 0, 0);
            }
        }
    }
    if (SAMPLE) { if (fr < 4) { bf16_t* op = XO + qrow * DM + h * 256 + 32 * wave + 4 * fq; *(u32x2*)op = pk4(O[0] * inv); *(u32x2*)(op + 16) = pk4(O[NO > 1 ? 1 : 0] * inv); } }
    else { bf16_t* op = XO + qrow * DM + h * 256 + 4 * fq;
#pragma unroll
        for (int n = 0; n < NO; ++n) *(u32x2*)(op + 16 * n) = pk4(O[n] * inv); }
}

template <int KSPLIT, class F>
__device__ __forceinline__ void skinny_gemm(const bf16_t* A, const bf16_t* Bt, int N, int K, const F& f, LAS unsigned char* lds, int bx, int G, int wave) {
    const int lane = lane_id_v(), fr = lane & 15, fq = lane >> 4;
    constexpr int MTW = 8 / KSPLIT, RG = 8 / MTW;
    const int ntiles = RG * (N / 16), klen = K / KSPLIT;
    for (int t = bx; t < ntiles; t += G) {
        const int rg = t % RG, n0 = (t / RG) * 16;
        const int mt = rg * MTW + (wave % MTW), kq = wave / MTW;
        const bf16_t* ap = A + (size_t)(MP + 16 * mt + fr) * K + kq * klen + 8 * fq;
        const bf16_t* bp = Bt + (size_t)(n0 + fr) * K + kq * klen + 8 * fq;
        f32x4 acc = (f32x4){0.f, 0.f, 0.f, 0.f};
#pragma unroll 16
        for (int k = 0; k < klen; k += 32) {
            const bf16x8 af = *(const bf16x8*)(ap + k), bf = *(const bf16x8*)(bp + k);
            acc = __builtin_amdgcn_mfma_f32_16x16x32_bf16(bf, af, acc, 0, 0, 0);
        }
        if (KSPLIT > 1) {
            __syncthreads();
            *(LAS f32x4*)(lds + wave * 1024 + lane * 16) = acc;
            __syncthreads();
            if (kq == 0) {
#pragma unroll
                for (int q = 1; q < KSPLIT; ++q) acc = acc + *(const LAS f32x4*)(lds + (wave + q * MTW) * 1024 + lane * 16);
                f.sk(MP + 16 * mt + fr, n0 + 4 * fq, acc, fq);
            }
        } else f.sk(MP + 16 * mt + fr, n0 + 4 * fq, acc, fq);
    }
}

__global__ void __launch_bounds__(NWAVES * 64, 2) mega(Args args) {
    extern __shared__ __attribute__((aligned(16))) unsigned char lds_raw[];
    LAS unsigned char* lds = (LAS unsigned char*)lds_raw;
    const int wave = __builtin_amdgcn_readfirstlane((int)threadIdx.x >> 6);
    const int G = gridDim.x, bx = blockIdx.x;
    const int gw_ = bx * NWAVES + wave, NGW = G * NWAVES;
    unsigned char* ws = args.ws; float* out = args.out;
    float* ROPE = (float*)(ws + WS_ROPE);
    bf16_t* WIN = (bf16_t*)(ws + WS_WIN); bf16_t* WMIX = (bf16_t*)(ws + WS_WMIX); bf16_t* WXQ = (bf16_t*)(ws + WS_WXQ); bf16_t* WXKV = (bf16_t*)(ws + WS_WXKV);
    bf16_t* WXO = (bf16_t*)(ws + WS_WXO); bf16_t* WUP = (bf16_t*)(ws + WS_WUP); bf16_t* WDN = (bf16_t*)(ws + WS_WDN); bf16_t* WSP = (bf16_t*)(ws + WS_WSP);
    bf16_t* MEMB = (bf16_t*)(ws + WS_MEMB); bf16_t* MKV = (bf16_t*)(ws + WS_MKV);
    bf16_t* XB = (bf16_t*)(ws + WS_XB);
    bf16_t* Qb = (bf16_t*)(ws + WS_Q); bf16_t* Kb = (bf16_t*)(ws + WS_K); bf16_t* Vb = (bf16_t*)(ws + WS_V); bf16_t* Ub = (bf16_t*)(ws + WS_U); bf16_t* Gb = (bf16_t*)(ws + WS_G);
    bf16_t* CAT = (bf16_t*)(ws + WS_CAT); float* LSE = (float*)(ws + WS_LSE);
    bf16_t* XQ = (bf16_t*)(ws + WS_XQ); bf16_t* XO = (bf16_t*)(ws + WS_XO); bf16_t* H = (bf16_t*)(ws + WS_H);
    const int lo = args.ph_lo, hi = args.ph_hi;
    int ph = 0;
    cg::grid_group grid = cg::this_grid();
    volatile LAS unsigned* misc = (volatile LAS unsigned*)(lds + LDS_BYTES - 64);
    if (wave == 0) { const int l0 = lane_id_v(); if (l0 < 2) misc[l0] = 0u; }
    __syncthreads();
    XcdBarrier xbar; xbar.bar = g_bar; xbar.x = 0; xbar.st = misc;
    if (hi - lo > 1) xbar = xcd_barrier_post(g_bar, misc, wave);
    if (lo < 0) grid.sync();
#ifndef PHMASK
#define PHMASK 0xFFFF
#endif
#define PON(k) ((PHMASK >> (k)) & 1)
#ifndef REPMASK
#define REPMASK 0
#endif
#define NREP(k) (((REPMASK >> (k)) & 1) ? 2 : 1)
#define RUN (ph >= lo && ph < hi)
#define OPAQ() const int lane = lane_id_v(), tid = wave * 64 + lane; int gw = gw_; asm volatile("" : "+s"(gw)); (void)lane; (void)gw; (void)tid;
#define SEAM() do { if (ph >= lo && ph + 1 < hi) xcd_barrier(xbar, wave); ++ph; } while (0)

    float* CV = (float*)(ws + WS_CV); float* CVP = (float*)(ws + WS_CVP); float* STM = (float*)(ws + WS_STM); float* STS = (float*)(ws + WS_STS); float* GST = (float*)(ws + WS_GST); bf16_t* ZB = (bf16_t*)(ws + WS_ZB);
    if (RUN && PON(0)) for (int rep_ = 0; rep_ < NREP(0); ++rep_) { OPAQ();
        LAS float* scr = (LAS float*)(lds + wave * 16896);
        {
            constexpr int I_IN = 16 * (INC / 32), I_SQ = 16 * 32, I_KV = 16 * 64, I_UP = 16 * 128, I_DN = 64 * 32;
            constexpr int NIT = I_IN + 3 * I_SQ + I_KV + I_UP + I_DN;
            auto mk = [&](int it) -> TDesc {
                const int l = it / NIT; int r = it % NIT; TDesc d; d.gsc = nullptr; d.bsc = nullptr; d.cvp = nullptr; d.K = DM;
                if (r < I_IN) { d.W = args.in[7] + (size_t)l * DM * INC; d.N = INC; d.WT = WIN + (size_t)l * INC * DM; d.item = r;
                    if (l > 0) { d.gsc = args.in[22] + (l - 1) * DM; d.bsc = args.in[23] + (l - 1) * DM; d.cvp = CVP + (size_t)(l * 3 + 0) * 16 * 2 * 4096; } return d; } r -= I_IN;
                if (r < I_SQ) { d.W = args.in[12] + (size_t)l * DM * DM; d.N = DM; d.WT = WMIX + (size_t)l * DM * DM; d.item = r; return d; } r -= I_SQ;
                if (r < I_SQ) { d.W = args.in[15] + (size_t)l * DM * DM; d.N = DM; d.WT = WXQ + (size_t)l * DM * DM; d.item = r;
                    d.gsc = args.in[13] + l * DM; d.bsc = args.in[14] + l * DM; d.cvp = CVP + (size_t)(l * 3 + 1) * 16 * 2 * 4096; return d; } r -= I_SQ;
                if (r < I_SQ) { d.W = args.in[17] + (size_t)l * DM * DM; d.N = DM; d.WT = WXO + (size_t)l * DM * DM; d.item = r; return d; } r -= I_SQ;
                if (r < I_KV) { d.W = args.in[16] + (size_t)l * DM * 2048; d.N = 2048; d.WT = WXKV + (size_t)l * 2048 * DM; d.item = r; return d; } r -= I_KV;
                if (r < I_UP) { d.W = args.in[20] + (size_t)l * DM * FF; d.N = FF; d.WT = WUP + (size_t)l * FF * DM; d.item = r;
                    d.gsc = args.in[18] + l * DM; d.bsc = args.in[19] + l * DM; d.cvp = CVP + (size_t)(l * 3 + 2) * 16 * 2 * 4096; return d; } r -= I_UP;
                d.W = args.in[21] + (size_t)l * FF * DM; d.N = DM; d.K = FF; d.WT = WDN + (size_t)l * DM * FF; d.item = r; return d;
            };
            for (int it = gw; it < DEPTH * NIT; it += 2 * NGW) {
                const bool two = it + NGW < DEPTH * NIT;
                const TDesc da = mk(it), db = mk(two ? it + NGW : it);
                float wa[32], wb[32];
                p0_load(da, wa, lane);
                if (two) p0_load(db, wb, lane);
                p0_finish(da, wa, scr, lane);
                if (two) p0_finish(db, wb, scr + 64 * 33, lane);
            }
        }
#pragma unroll 2
        for (int row = gw; row < MR + 2048; row += NGW) {
            const float* src = row < MP ? args.in[0] + (size_t)row * DM : (row < MR ? args.in[1] + (size_t)(row - MP) * DM : args.in[6] + (size_t)(row - MR) * DM);
            bf16_t* dstp = row < MR ? XB + (size_t)row * DM : MEMB + (size_t)(row - MR) * DM;
            const f32x4* s4 = (const f32x4*)src + lane; u32x2* ob = (u32x2*)dstp + lane;
#pragma unroll
            for (int j = 0; j < 4; ++j) ob[64 * j] = pk4(s4[64 * j]);
        }
        for (int e = bx * 512 + tid; e < DEPTH * 4 * 128 * 128; e += G * 512) { const int s = e & 127, t = (e >> 7) & 127; WSP[e] = s <= t ? (bf16_t)f2bf(args.in[10][e]) : (bf16_t)0; }
        for (int e = bx * 512 + tid; e < 2052 * 8; e += G * 512) {
            const int pi = e >> 3, i = e & 7; const float pos = (float)(pi < 2048 ? pi : 8192 + pi - 2048);
            const float inv = i == 0 ? 1.0f : i == 1 ? 0.19392274474868576f : i == 2 ? 0.03760603093086393f : i == 3 ? 0.007292664737217109f :
                              i == 4 ? 0.001414213562373095f : i == 5 ? 0.0002742481756762073f : i == 6 ? 5.318295896944988e-05f : 1.031338537721246e-05f;
            const float ang = pos * inv;
            const double x = (double)ang, kq = __builtin_rint(x * 0.15915494309189535), rr = (x - kq * 6.283185307179586) , r2 = rr * rr;
            double sn = 0.0, ts = rr, cs = 0.0, tc = 1.0;
            for (int n = 0; n < 16; ++n) { sn += ts; cs += tc; tc *= -r2 / (double)((2 * n + 1) * (2 * n + 2)); ts *= -r2 / (double)((2 * n + 2) * (2 * n + 3)); }
            ROPE[pi * 16 + i] = (float)cs; ROPE[pi * 16 + 8 + i] = (float)sn;
        }
    }
    SEAM();

    int sb = 0;
    for (int l = 0; l < DEPTH; ++l) {
        const float* cvl = CV + (size_t)l * 3 * 2 * 4096;
        if (RUN && PON(1)) for (int rep_ = 0; rep_ < NREP(1); ++rep_) {
            { const bf16_t* Ain = l == 0 ? XB : ZB;
              pg8::Gemm g{Ain, WIN + (size_t)l * INC * DM, MP, INC, DM}; pg8::StaticOrder S; S.init(MP, INC, G, bx);
              EpiFold<FProj> E{FProj{Qb, Kb, Vb, Ub, Gb, ROPE, out, l, GST}, l > 0, STM + (size_t)sb * MP * 32, STS + (size_t)sb * 128 * 128, cvl, cvl + 4096};
              pg8::gemm_phase(lds, g, S, E, wave);
              skinny_gemm<1>(Ain, WIN + (size_t)l * INC * DM, INC, DM, E, lds, G - 1 - bx, G, wave); }
            if (bx >= G - 64) { pg8::Gemm g{MEMB, WXKV + (size_t)l * 2048 * DM, 2048, 2048, DM}; pg8::StaticOrder S; S.init(2048, 2048, 64, bx - (G - 64));
              pg8::EpiWrap<FMkv> E{FMkv{out, MKV, l}};
              pg8::gemm_phase(lds, g, S, E, wave); }
        }
        SEAM();
        if (RUN && PON(2)) for (int rep_ = 0; rep_ < NREP(2); ++rep_) { OPAQ();
            if (l == 0 && rep_ == 0) {
                for (int e = bx * 512 + tid; e < DEPTH * 3 * 2 * 4096; e += G * 512) {
                    const int lw = e / 8192, rem = e % 8192; const float* p = CVP + (size_t)lw * 16 * 8192 + rem; float a = 0.f;
#pragma unroll
                    for (int kb = 0; kb < 16; ++kb) a += p[kb * 8192];
                    CV[e] = a;
                }
            }
            LAS unsigned char* vl = lds + wave * 5120;
            LAS unsigned char* otile = lds + 40960;
            LAS float* lsel = (LAS float*)(lds + 40960 + 98304);
            for (int u = bx; u < DECB * 4; u += G) {
                const int b = u >> 2, hs = u & 3;
                __syncthreads();
                for (int j = wave; j < 12; j += NWAVES) {
                    const int g = j >> 2, qi = j & 3;
                    attn_tile<true>(Qb, Kb, Vb, args.in[2], args.in[3], args.in[4], l, otile + j * 128, lsel + g * 4 + qi, vl, b, g * 4 + hs, qi, 0, lane);
                }
                __syncthreads();
                if (tid < 96) {
                    const int j = tid >> 3, seg = tid & 7, g = j >> 2, qi = j & 3;
                    const float l0 = lsel[qi], l1 = lsel[4 + qi], l2 = lsel[8 + qi], mx = fmaxf(l0, fmaxf(l1, l2));
                    const float e0 = __expf(l0 - mx), e1 = __expf(l1 - mx), e2 = __expf(l2 - mx);
                    const float w = (g == 0 ? e0 : (g == 1 ? e1 : e2)) * __builtin_amdgcn_rcpf(e0 + e1 + e2);
                    const u32x4 v = *(const LAS u32x4*)(otile + j * 128 + seg * 16);
                    u32x4 o; o.x = pk2(bflo(v.x) * w, bfhi(v.x) * w); o.y = pk2(bflo(v.y) * w, bfhi(v.y) * w); o.z = pk2(bflo(v.z) * w, bfhi(v.z) * w); o.w = pk2(bflo(v.w) * w, bfhi(v.w) * w);
                    *(u32x4*)(CAT + ((size_t)MP + b * 4 + qi) * DM + (g * 4 + hs) * 64 + seg * 8) = o;
                }
            }
            for (int u = bx; u < NB * 4 * 8; u += G) {
                const int uu = (G == 256) ? ((u & 7) * 32 + (u >> 3)) : u;
                const int b = uu >> 5, hs = (uu >> 3) & 3, blk = uu & 7;
                __syncthreads();
#pragma unroll 1
                for (int i = 0; i < 6; ++i) {
                    const int j = wave + 8 * i, g = j >> 4, idx = j & 15;
                    const int r = g == 0 ? 0 : (g == 1 ? (idx & 3) : idx), sb = g == 0 ? blk * 16 + idx : (g == 1 ? blk * 4 + (idx >> 2) : blk);
                    const int tk = (((16 * sb + (lane & 15)) << (2 * g)) + r) - 256 * blk;
                    attn_tile<false>(Qb, Kb, Vb, args.in[2], args.in[3], args.in[4], l, otile + (j * 16 + (lane & 15)) * 128, lsel + g * 256 + tk, vl, b, g * 4 + hs, r, sb, lane);
                }
                __syncthreads();
#pragma unroll 2
                for (int p = 0; p < 12; ++p) {
                    const int rowi = (tid >> 3) + 64 * p, seg = tid & 7, j = rowi >> 4, q = rowi & 15, g = j >> 4, idx = j & 15;
                    const int r = g == 0 ? 0 : (g == 1 ? (idx & 3) : idx), sb = g == 0 ? blk * 16 + idx : (g == 1 ? blk * 4 + (idx >> 2) : blk);
                    const int tk = (((16 * sb + q) << (2 * g)) + r) - 256 * blk;
                    const float l0 = lsel[tk], l1 = lsel[256 + tk], l2 = lsel[512 + tk], mx = fmaxf(l0, fmaxf(l1, l2));
                    const float e0 = __expf(l0 - mx), e1 = __expf(l1 - mx), e2 = __expf(l2 - mx);
                    const float w = (g == 0 ? e0 : (g == 1 ? e1 : e2)) * __builtin_amdgcn_rcpf(e0 + e1 + e2);
                    const u32x4 v = *(const LAS u32x4*)(otile + rowi * 128 + seg * 16);
                    u32x4 o; o.x = pk2(bflo(v.x) * w, bfhi(v.x) * w); o.y = pk2(bflo(v.y) * w, bfhi(v.y) * w); o.z = pk2(bflo(v.z) * w, bfhi(v.z) * w); o.w = pk2(bflo(v.w) * w, bfhi(v.w) * w);
                    *(u32x4*)(CAT + ((size_t)b * SEQ + 256 * blk + tk) * DM + (g * 4 + hs) * 64 + seg * 8) = o;
                }
            }
            __syncthreads();
            const float* sg = args.in[8] + l * 256; const float* sb_ = args.in[9] + l * 256;
            for (int b = gw; b < DECB; b += NGW) {
                const f32x4 gg = *(const f32x4*)(sg + 4 * lane), bb = *(const f32x4*)(sb_ + 4 * lane);
                const int g = lane >> 4;
                f32x4 gvv[4];
#pragma unroll
                for (int i = 0; i < 4; ++i) {
                    const size_t row = (size_t)MP + b * 4 + i;
                    const u32x2 raw = *((const u32x2*)(Gb + row * 256) + lane);
                    f32x4 v = (f32x4){bflo(raw.x), bfhi(raw.x), bflo(raw.y), bfhi(raw.y)};
                    const float mean = wave_sum((v.x + v.y) + (v.z + v.w)) * (1.f / 256.f);
                    v = v - mean;
                    const float rstd = 1.f / sqrtf(wave_sum((v.x * v.x + v.y * v.y) + (v.z * v.z + v.w * v.w)) * (1.f / 256.f) + LN_EPS);
                    gvv[i] = v * rstd * gg + bb;
                    *(f32x4*)(out + O9 + (((size_t)l * DECB + b) * 4 + i) * 256 + 4 * lane) = gvv[i];
                }
#pragma unroll
                for (int i = 0; i < 4; ++i) {
                    const size_t row = (size_t)MP + b * 4 + i;
                    const float* wsp = args.in[10] + (((size_t)l * 4 + g) * 128 + i) * 128;
                    const float bs = args.in[11][((size_t)l * 4 + g) * 128 + i];
                    f32x4 mx = (f32x4){bs, bs, bs, bs};
#pragma unroll
                    for (int s = 0; s <= i; ++s) mx = mx + gvv[s] * wsp[s];
                    const u32x2 ur = *((const u32x2*)(Ub + row * 256) + lane);
                    f32x4 u = (f32x4){bflo(ur.x), bfhi(ur.x), bflo(ur.y), bfhi(ur.y)};
                    *((u32x2*)(CAT + row * DM + ATT) + lane) = pk4(u * mx);
                }
            }
            const int nsgu = G == 256 ? (bx < 128 ? 1 : 3) : (128 * 4 - bx + G - 1) / G;
            for (int ui = 0; ui < nsgu; ++ui) {
                const int unit = G == 256 ? (bx < 128 ? bx : 128 + 3 * (bx - 128) + ui) : bx + ui * G;
                const int ck = unit >> 2, g = unit & 3; const size_t R0 = (size_t)ck * 128;
                __syncthreads();
                LAS float* stl = (LAS float*)(lds + 24576);
                if (tid < 128) {
                    const f32x4* p = (const f32x4*)(GST + (R0 + tid) * 8); const f32x4 a = p[0], b = p[1];
                    const float s1 = (a.x + a.z) + (b.x + b.z), s2 = (a.y + a.w) + (b.y + b.w);
                    const float mean = s1 * (1.f / 256.f); stl[2 * tid] = mean; stl[2 * tid + 1] = 1.f / sqrtf(fmaxf(s2 * (1.f / 256.f) - mean * mean, 0.f) + LN_EPS);
                }
                __syncthreads();
                {
                    const int rr = tid >> 2, cs = (tid & 3) * 16; const float mean = stl[2 * rr], rstd = stl[2 * rr + 1];
                    const u32x4* gp = (const u32x4*)(Gb + (R0 + rr) * 256 + g * 64 + cs);
                    const float* sgp = sg + g * 64 + cs; const float* sbp = sb_ + g * 64 + cs;
#pragma unroll
                    for (int q = 0; q < 2; ++q) {
                        const u32x4 raw = gp[q];
                        const f32x4 g0 = *(const f32x4*)(sgp + 8 * q), g1 = *(const f32x4*)(sgp + 8 * q + 4), b0 = *(const f32x4*)(sbp + 8 * q), b1 = *(const f32x4*)(sbp + 8 * q + 4);
                        const f32x4 v0 = ((f32x4){bflo(raw.x), bfhi(raw.x), bflo(raw.y), bfhi(raw.y)} - mean) * rstd * g0 + b0;
                        const f32x4 v1 = ((f32x4){bflo(raw.z), bfhi(raw.z), bflo(raw.w), bfhi(raw.w)} - mean) * rstd * g1 + b1;
                        u32x4 o; o.x = pk2(v0.x, v0.y); o.y = pk2(v0.z, v0.w); o.z = pk2(v1.x, v1.y); o.w = pk2(v1.z, v1.w);
                        *(LAS u32x4*)(lds + rr * 160 + cs * 2 + q * 16) = o;
                    }
                }
                __syncthreads();
                const int fr = lane & 15, fq = lane >> 4, mt = wave;
                f32x4 acc[4];
#pragma unroll
                for (int n = 0; n < 4; ++n) acc[n] = (f32x4){0.f, 0.f, 0.f, 0.f};
                const bf16_t* wrow = WSP + (((size_t)l * 4 + g) * 128 + 16 * mt + fr) * 128;
                const LAS unsigned char* trp = lds + (4 * fq + (fr >> 2)) * 160 + (lane & 3) * 8;
                for (int sk = 0; sk <= (mt >> 1); ++sk) {
                    const u32x2 w0 = *(const u32x2*)(wrow + 32 * sk + 4 * fq), w1 = *(const u32x2*)(wrow + 32 * sk + 16 + 4 * fq);
                    u32x4 wv; wv.x = w0.x; wv.y = w0.y; wv.z = w1.x; wv.w = w1.y;
                    const bf16x8 wb = __builtin_bit_cast(bf16x8, wv);
#pragma unroll
                    for (int n = 0; n < 4; ++n) {
                        const s16x4 lo = vtr(trp + sk * 32 * 160 + n * 32), hi = vtr(trp + sk * 32 * 160 + 16 * 160 + n * 32);
                        bf16x8 va; va[0] = lo[0]; va[1] = lo[1]; va[2] = lo[2]; va[3] = lo[3]; va[4] = hi[0]; va[5] = hi[1]; va[6] = hi[2]; va[7] = hi[3];
                        acc[n] = __builtin_amdgcn_mfma_f32_16x16x32_bf16(va, wb, acc[n], 0, 0, 0);
                    }
                }
                const int t = 16 * mt + fr; const float bs = args.in[11][((size_t)l * 4 + g) * 128 + t];
#pragma unroll
                for (int n = 0; n < 4; ++n) {
                    const u32x2 ur = *(const u32x2*)(Ub + (R0 + t) * 256 + g * 64 + 16 * n + 4 * fq);
                    const f32x4 u = (f32x4){bflo(ur.x), bfhi(ur.x), bflo(ur.y), bfhi(ur.y)};
                    *(u32x2*)(CAT + (R0 + t) * DM + ATT + g * 64 + 16 * n + 4 * fq) = pk4(u * (acc[n] + bs));
                }
            }
        }
        SEAM();
        if (RUN && PON(4)) for (int rep_ = 0; rep_ < NREP(4); ++rep_) {
            pg8::Gemm g{CAT, WMIX + (size_t)l * DM * DM, MP, DM, DM}; pg8::StaticOrder S; S.init(MP, DM, G, bx);
            EpiRes E{l == 0 ? XB : ZB, ZB, l > 0, STM + (size_t)sb * MP * 32, STS + (size_t)sb * 128 * 128, args.in[22] + (l > 0 ? l - 1 : 0) * DM, args.in[23] + (l > 0 ? l - 1 : 0) * DM,
                     STM + (size_t)(sb ^ 1) * MP * 32, STS + (size_t)(sb ^ 1) * 128 * 128};
            pg8::gemm_phase(lds, g, S, E, wave);
            skinny_gemm<4>(CAT, WMIX + (size_t)l * DM * DM, DM, DM, E, lds, bx, G, wave); }
        SEAM(); sb ^= 1;
        if (RUN && PON(6)) for (int rep_ = 0; rep_ < NREP(6); ++rep_) {
            pg8::Gemm g{ZB, WXQ + (size_t)l * DM * DM, MP, DM, DM}; pg8::StaticOrder S; S.init(MP, DM, G, bx);
            EpiFold<FScaleBf> E{FScaleBf{XQ, DM, XQSCALE}, true, STM + (size_t)sb * MP * 32, STS + (size_t)sb * 128 * 128, cvl + 2 * 4096, cvl + 3 * 4096};
            pg8::gemm_phase(lds, g, S, E, wave);
            skinny_gemm<4>(ZB, WXQ + (size_t)l * DM * DM, DM, DM, E, lds, bx, G, wave); }
        SEAM();
        if (RUN && PON(7)) for (int rep_ = 0; rep_ < NREP(7); ++rep_) { OPAQ();
            const float* cmem = args.in[5] + (size_t)l * DECB * 256 * 2048; const bf16_t* MKVl = MKV + (size_t)l * 2048 * 2048;
            constexpr int NU = DECB * 4 + NB * 4 * 16;
            u32x4 kpre[8];
            if (G == 256) {
                const int xcd = bx & 7, slot = bx >> 3, nun = slot < 16 ? 2 : 3;
                for (int i = 0; i < nun; ++i) {
                    int u;
                    if (slot < 16 && i == 0) u = xcd * 16 + slot;
                    else { const int idx = slot < 16 ? slot : 16 + 3 * (slot - 16) + i; u = DECB * 4 + (xcd + 8 * (idx >> 4)) * 16 + (idx & 15); }
                    if (u < DECB * 4) xattn_unit<true>(XQ, MKVl, cmem, XO, lds, u, -1, kpre, wave);
                    else xattn_unit<false>(XQ, MKVl, cmem, XO, lds, u, -1, kpre, wave);
                }
            } else
            for (int u = bx; u < NU; u += G) {
                if (u < DECB * 4) xattn_unit<true>(XQ, MKVl, cmem, XO, lds, u, -1, kpre, wave);
                else xattn_unit<false>(XQ, MKVl, cmem, XO, lds, u, -1, kpre, wave);
            }
            __syncthreads();
        }
        SEAM();
        if (RUN && PON(8)) for (int rep_ = 0; rep_ < NREP(8); ++rep_) {
            pg8::Gemm g{XO, WXO + (size_t)l * DM * DM, MP, DM, DM}; pg8::StaticOrder S; S.init(MP, DM, G, bx);
            EpiRes E{ZB, ZB, true, STM + (size_t)sb * MP * 32, STS + (size_t)sb * 128 * 128, args.in[13] + l * DM, args.in[14] + l * DM,
                     STM + (size_t)(sb ^ 1) * MP * 32, STS + (size_t)(sb ^ 1) * 128 * 128};
            pg8::gemm_phase(lds, g, S, E, wave);
            skinny_gemm<4>(XO, WXO + (size_t)l * DM * DM, DM, DM, E, lds, bx, G, wave); }
        SEAM(); sb ^= 1;
        if (RUN && PON(10)) for (int rep_ = 0; rep_ < NREP(10); ++rep_) {
            pg8::Gemm g{ZB, WUP + (size_t)l * FF * DM, MP, FF, DM}; pg8::StaticOrder S; S.init(MP, FF, G, bx);
            EpiFold<FRelu2> E{FRelu2{H}, true, STM + (size_t)sb * MP * 32, STS + (size_t)sb * 128 * 128, cvl + 4 * 4096, cvl + 5 * 4096};
            pg8::gemm_phase(lds, g, S, E, wave);
            skinny_gemm<1>(ZB, WUP + (size_t)l * FF * DM, FF, DM, E, lds, bx, G, wave); }
        SEAM();
        if (RUN && PON(11)) for (int rep_ = 0; rep_ < NREP(11); ++rep_) {
            pg8::Gemm g{H, WDN + (size_t)l * DM * FF, MP, DM, FF}; pg8::StaticOrder S; S.init(MP, DM, G, bx);
            EpiRes E{ZB, ZB, true, STM + (size_t)sb * MP * 32, STS + (size_t)sb * 128 * 128, args.in[18] + l * DM, args.in[19] + l * DM,
                     STM + (size_t)(sb ^ 1) * MP * 32, STS + (size_t)(sb ^ 1) * 128 * 128};
            pg8::gemm_phase(lds, g, S, E, wave);
            skinny_gemm<4>(H, WDN + (size_t)l * DM * FF, DM, FF, E, lds, bx, G, wave); }
        SEAM(); sb ^= 1;
    }
    if (RUN && PON(12)) for (int rep_ = 0; rep_ < NREP(12); ++rep_) { OPAQ(); final_ln(ZB, args.in[22] + (DEPTH - 1) * DM, args.in[23] + (DEPTH - 1) * DM, out, gw, NGW, lane); }
    SEAM();
    if (hi - lo > 1) {
        __syncthreads();
        if (wave == 0 && lane_id_v() == 0) {
            const unsigned old = xb_add(&g_bar[XB_DONE], 1u);
            if (old + 1u == (unsigned)G) {
#pragma unroll 1
                for (int j = 0; j < 16; ++j) {
                    __hip_atomic_store(&g_bar[XB_XCNT(j)], 0u, __ATOMIC_RELAXED, __HIP_MEMORY_SCOPE_AGENT);
                    __hip_atomic_store(&g_bar[XB_XSUB(j)], 0u, __ATOMIC_RELAXED, __HIP_MEMORY_SCOPE_AGENT);
                    __hip_atomic_store(&g_bar[XB_XGEN(j)], 0u, __ATOMIC_RELAXED, __HIP_MEMORY_SCOPE_AGENT);
                }
                __hip_atomic_store(&g_bar[XB_TOP], 0u, __ATOMIC_RELAXED, __HIP_MEMORY_SCOPE_AGENT);
                __hip_atomic_store(&g_bar[XB_TOPGEN], 0u, __ATOMIC_RELAXED, __HIP_MEMORY_SCOPE_AGENT);
                __hip_atomic_store(&g_bar[XB_TMO], 0u, __ATOMIC_RELAXED, __HIP_MEMORY_SCOPE_AGENT);
                __hip_atomic_store(&g_bar[XB_DONE], 0u, __ATOMIC_RELAXED, __HIP_MEMORY_SCOPE_AGENT);
            }
        }
    }
#undef RUN
#undef SEAM
}
constexpr int N_PHASES = 2 + DEPTH * 8;

extern "C" void kernel_launch(void* const* d_in, const int* in_sizes, int n_in, void* d_out, int out_size, void* d_ws, size_t ws_size, hipStream_t stream) {
    static int grid = 0;
    if (grid == 0) {
        if (n_in != 24 || ws_size < WS_END) { fprintf(stderr, "kernel_launch: need 24 inputs and %zu bytes of ws (got %d, %zu)\n", (size_t)WS_END, n_in, ws_size); grid = -1; return; }
        int dev = 0, cus = 0, per_cu = 0;
        hipGetDevice(&dev); hipDeviceGetAttribute(&cus, hipDeviceAttributeMultiprocessorCount, dev);
        if (hipFuncSetAttribute((const void*)mega, hipFuncAttributeMaxDynamicSharedMemorySize, LDS_BYTES) != hipSuccess) { fprintf(stderr, "kernel_launch: hipFuncSetAttribute failed\n"); grid = -1; return; }
        hipOccupancyMaxActiveBlocksPerMultiprocessor(&per_cu, (const void*)mega, NWAVES * 64, LDS_BYTES);
        if (per_cu < 1) { fprintf(stderr, "kernel_launch: occupancy query says %d blocks/CU\n", per_cu); per_cu = 1; }
        (void)hipGetLastError();
        grid = cus * 1;
    }
    if (grid < 0) return;
    Args a{};
    for (int i = 0; i < 24; ++i) a.in[i] = (const float*)d_in[i];
    a.out = (float*)d_out; a.ws = (unsigned char*)d_ws;
#if MK_MULTI
    for (int p = 0; p < N_PHASES; ++p) {
        a.ph_lo = p; a.ph_hi = p + 1;
        hipLaunchKernelGGL(mega, dim3(grid), dim3(NWAVES * 64), LDS_BYTES, stream, a);
    }
#else
    a.ph_lo = 0; a.ph_hi = N_PHASES;
    void* kargs[] = {&a};
    hipError_t e = hipLaunchCooperativeKernel((const void*)mega, dim3(grid), dim3(NWAVES * 64), kargs, LDS_BYTES, stream);
    if (e != hipSuccess) fprintf(stderr, "cooperative launch failed: %s (grid %d)\n", hipGetErrorString(e), grid);
#endif
}
```

```cpp
#include <hip/hip_runtime.h>
#include <hip/hip_cooperative_groups.h>
#include <cstdio>
#include <cstdint>
namespace cg = cooperative_groups;

#ifndef MK_MULTI
#define MK_MULTI 0
#endif

#define LAS __attribute__((address_space(3)))
typedef unsigned short bf16_t;
typedef short bf16x8 __attribute__((ext_vector_type(8)));
typedef short s16x4 __attribute__((ext_vector_type(4)));
typedef float f32x4 __attribute__((ext_vector_type(4)));
typedef unsigned u32x4 __attribute__((ext_vector_type(4)));
typedef unsigned u32x2 __attribute__((ext_vector_type(2)));

constexpr int DM = 1024, SEQ = 2048, NB = 8, DEPTH = 2, DECB = 32, DECS = 4;
constexpr int MP = NB * SEQ;
constexpr int MS = DECB * DECS;
constexpr int MR = MP + MS;
constexpr int MT = 16640;
constexpr int INC = 2816, ATT = 768, FF = 4096, NMEM = 256;
constexpr float LN_EPS = 1e-5f;
constexpr float ALPHA = 1.41421356237309515f;
constexpr float LOG2E = 1.4426950408889634f, LN2 = 0.6931471805599453f;
constexpr float QSCALE = 0.125f * LOG2E;
constexpr float XQSCALE = 0.0625f * LOG2E;

constexpr size_t O0 = 0, O1 = 16777216, O2 = 16908288, O3 = 17956864, O4 = 22151168, O5 = 38928384,
                 O6 = 47316992, O7 = 47448064, O8 = 47579136, O9 = 47710208;

constexpr size_t al256(size_t x) { return (x + 255) & ~(size_t)255; }
constexpr size_t WS_BAR = 0, WS_BAR_BYTES = 16384;
constexpr size_t WS_ROPE = 16384;
constexpr size_t WS_WIN = al256(WS_ROPE + 2052 * 16 * 4);
constexpr size_t WS_WMIX = WS_WIN + (size_t)DEPTH * INC * DM * 2;
constexpr size_t WS_WXQ = WS_WMIX + (size_t)DEPTH * DM * DM * 2;
constexpr size_t WS_WXKV = WS_WXQ + (size_t)DEPTH * DM * DM * 2;
constexpr size_t WS_WXO = WS_WXKV + (size_t)DEPTH * 2 * DM * DM * 2;
constexpr size_t WS_WUP = WS_WXO + (size_t)DEPTH * DM * DM * 2;
constexpr size_t WS_WDN = WS_WUP + (size_t)DEPTH * FF * DM * 2;
constexpr size_t WS_WSP = WS_WDN + (size_t)DEPTH * FF * DM * 2;
constexpr size_t WS_MEMB = WS_WSP + (size_t)DEPTH * 4 * 128 * 128 * 2;
constexpr size_t WS_MKV = WS_MEMB + (size_t)2048 * DM * 2;
constexpr size_t WS_CV = WS_MKV + (size_t)DEPTH * 2048 * 2048 * 2;
constexpr size_t WS_CVP = WS_CV + (size_t)DEPTH * 3 * 2 * 4096 * 4;
constexpr size_t WS_STM = WS_CVP + (size_t)DEPTH * 3 * 16 * 2 * 4096 * 4;
constexpr size_t WS_STS = WS_STM + (size_t)2 * MP * 32 * 4;
constexpr size_t WS_GST = WS_STS + (size_t)2 * 128 * 128 * 4;
constexpr size_t WS_ZB = WS_GST + (size_t)MP * 8 * 4;
constexpr size_t WS_XB = WS_ZB + (size_t)MT * DM * 2;
constexpr size_t WS_Q = WS_XB + (size_t)MT * DM * 2;
constexpr size_t WS_K = WS_Q + (size_t)MT * ATT * 2;
constexpr size_t WS_V = WS_K + (size_t)MT * ATT * 2;
constexpr size_t WS_U = WS_V + (size_t)MT * ATT * 2;
constexpr size_t WS_G = WS_U + (size_t)MT * 256 * 2;
constexpr size_t WS_CAT = WS_G + (size_t)MT * 256 * 2;
constexpr size_t WS_LSE = WS_CAT + (size_t)MT * DM * 2;
constexpr size_t WS_XQ = WS_LSE + (size_t)MT * 16 * 4;
constexpr size_t WS_XO = WS_XQ + (size_t)MT * DM * 2;
constexpr size_t WS_H = WS_XO + (size_t)MT * DM * 2;
constexpr size_t WS_END = WS_H + (size_t)MT * FF * 2;

constexpr int LDS_BYTES = 147456;
constexpr int NWAVES = 8;

__device__ __forceinline__ unsigned f2bf(float f) { unsigned u = __builtin_bit_cast(unsigned, f); return (u + 0x7fffu + ((u >> 16) & 1u)) >> 16; }
typedef float f32x2_t __attribute__((ext_vector_type(2))); typedef __bf16 bf16x2_t __attribute__((ext_vector_type(2)));
__device__ __forceinline__ unsigned pk2(float lo, float hi) { const f32x2_t v = {lo, hi}; const bf16x2_t b = __builtin_convertvector(v, bf16x2_t); return __builtin_bit_cast(unsigned, b); }
__device__ __forceinline__ float bf2f(unsigned short h) { return __builtin_bit_cast(float, (unsigned)h << 16); }
__device__ __forceinline__ float bflo(unsigned u) { return __builtin_bit_cast(float, u << 16); }
__device__ __forceinline__ float bfhi(unsigned u) { return __builtin_bit_cast(float, u & 0xffff0000u); }
__device__ __forceinline__ u32x2 pk4(f32x4 v) { u32x2 r; r.x = pk2(v.x, v.y); r.y = pk2(v.z, v.w); return r; }
__device__ __forceinline__ float wave_sum(float v) {
#pragma unroll
    for (int o = 1; o < 64; o <<= 1) v += __shfl_xor(v, o);
    return v;
}
__device__ __forceinline__ float gelu_tanh(float x) {
    const float t = x * (2.302208198f + 0.1029432397f * x * x);
    const float e = __builtin_amdgcn_exp2f(fminf(t, 80.f));
    return x - x * __builtin_amdgcn_rcpf(1.f + e);
}
__device__ __forceinline__ int lane_id_v() { int l; asm volatile("v_mbcnt_lo_u32_b32 %0, -1, 0\n\tv_mbcnt_hi_u32_b32 %0, -1, %0" : "=v"(l)); return l; }
#define LDS_WAIT() asm volatile("s_waitcnt lgkmcnt(0)" ::: "memory")
#define VM_WAIT() asm volatile("s_waitcnt vmcnt(0)" ::: "memory")
__device__ __forceinline__ s16x4 vtr(const LAS unsigned char* p) {
    return __builtin_bit_cast(s16x4, __builtin_amdgcn_ds_read_tr16_b64_v4i16((LAS s16x4*)p));
}


#define XB_DONE     3520
#define XB_TMO      128
#define XB_XCNT(j)  (256  + 64 * (j))
#define XB_XSUB(j)  (1280 + 64 * (j))
#define XB_XGEN(j)  (2304 + 64 * (j))
#define XB_TOP      3328
#define XB_TOPGEN   3392
#define XCD_BAR_WORDS 3456
#define XB_SPIN_CAP (1u << 22)
__device__ unsigned g_bar[3712];
__device__ __forceinline__ unsigned xb_ld(unsigned* p)              { return __hip_atomic_load(p, __ATOMIC_RELAXED, __HIP_MEMORY_SCOPE_AGENT); }
__device__ __forceinline__ unsigned xb_add(unsigned* p, unsigned v) { return __hip_atomic_fetch_add(p, v, __ATOMIC_RELAXED, __HIP_MEMORY_SCOPE_AGENT); }
__device__ __forceinline__ unsigned xb_xcc_id() { return (unsigned)__builtin_amdgcn_s_getreg((3 << 11) | 20) & 0xFu; }
#define XB_SPIN(cond, bar) do { unsigned _sp = 0; while (cond) { __builtin_amdgcn_s_sleep(1); \
    if ((++_sp & 255u) == 0u) { if (xb_ld(&(bar)[XB_TMO])) break; if (_sp > XB_SPIN_CAP) { atomicAdd(&(bar)[XB_TMO], 1u); break; } } } } while (0)
struct XcdBarrier { unsigned* bar; unsigned x; volatile LAS unsigned* st; };
__device__ __forceinline__ XcdBarrier xcd_barrier_post(unsigned* bar, volatile LAS unsigned* st, int wave) {
    XcdBarrier b; b.bar = bar; b.x = xb_xcc_id(); b.st = st;
    if (wave == 0 && lane_id_v() == 0) (void)xb_add(&bar[XB_XCNT(b.x)], 1u);
    return b;
}
__device__ __forceinline__ void xcd_barrier_complete(unsigned* bar, unsigned x, unsigned& nloc, unsigned& nx) {
    const unsigned G = gridDim.x * gridDim.y * gridDim.z;
    unsigned sum, cnt, mine, sp = 0u;
    for (;;) {
        sum = 0u; cnt = 0u; mine = 0u;
#pragma unroll
        for (unsigned j = 0; j < 16; ++j) { const unsigned c = xb_ld(&bar[XB_XCNT(j)]); sum += c; cnt += (c > 0u) ? 1u : 0u; mine = (j == x) ? c : mine; }
        if (sum == G) break;
        __builtin_amdgcn_s_sleep(1);
        if ((++sp & 255u) == 0u) { if (xb_ld(&bar[XB_TMO])) break; if (sp > XB_SPIN_CAP) { atomicAdd(&bar[XB_TMO], 1u); break; } }
    }
    nloc = mine > 0u ? mine : 1u; nx = cnt > 0u ? cnt : 1u;
}
__device__ __forceinline__ void xcd_barrier(const XcdBarrier& b, int wave) {
    asm volatile("s_waitcnt vmcnt(0)" ::: "memory");
    __syncthreads();
    if (wave == 0 && lane_id_v() == 0) {
        unsigned* bar = b.bar;
        __builtin_amdgcn_s_waitcnt(0);
        unsigned nloc = b.st[0], nx = b.st[1];
        if (nloc == 0u) { xcd_barrier_complete(bar, b.x, nloc, nx); b.st[0] = nloc; b.st[1] = nx; }
        const unsigned old = xb_add(&bar[XB_XSUB(b.x)], 1u);
        const unsigned gen = old / nloc;
        if (old + 1u == (gen + 1u) * nloc) {
            __builtin_amdgcn_fence(__ATOMIC_RELEASE, "agent");
            asm volatile("s_waitcnt vmcnt(0)" ::: "memory");
            const unsigned og = xb_add(&bar[XB_TOP], 1u);
            const unsigned tg = og / nx;
            if (og + 1u == (tg + 1u) * nx) xb_add(&bar[XB_TOPGEN], 1u);
            else XB_SPIN(xb_ld(&bar[XB_TOPGEN]) == tg, bar);
            __builtin_amdgcn_fence(__ATOMIC_ACQUIRE, "agent");
            xb_add(&bar[XB_XGEN(b.x)], 1u);
            asm volatile("s_waitcnt vmcnt(0)" ::: "memory");
        } else {
            XB_SPIN(xb_ld(&bar[XB_XGEN(b.x)]) == gen, bar);
            __builtin_amdgcn_fence(__ATOMIC_ACQUIRE, "agent");
            asm volatile("s_waitcnt vmcnt(0)" ::: "memory");
        }
    }
    __syncthreads();
}

namespace pg8 {
constexpr int BM = 256, BK = 64, HALF = 128, HTB = HALF * BK * 2, NXCD = 8, WGM = 8;
__host__ __device__ __forceinline__ int lds_byte(int r, int c) { const int st = (r >> 4) * 2 + (c >> 5), rr = r & 15, cc = c & 31, ob = rr * 64 + cc * 2; return st * 1024 + (ob ^ (((ob >> 9) & 1) << 5)); }
__host__ __device__ __forceinline__ void stage_rc(int b, int& R, int& C) { const int st = b / 1024, sb = b % 1024, swz = sb ^ (((sb >> 9) & 1) << 5); R = (st >> 1) * 16 + swz / 64; C = (st & 1) * 32 + (swz % 64) / 2; }
struct Unit { int pm, pn; };
struct Gemm { const bf16_t* A; const bf16_t* Bt; int M, N, K; };
struct StaticOrder {
    int nM, nN, nwg, G, c;
    __host__ __device__ void init(int M, int N, int G_, int c_) { nM = M / BM; nN = N / BM; nwg = nM * nN; G = G_; c = c_; }
    __host__ __device__ bool next(int i, Unit& u) const {
        const long L = (long)i * G + c; if (L >= nwg) return false;
        int wgid = (int)L; { const int q = nwg / NXCD, r = nwg % NXCD, xcd = wgid % NXCD, off = wgid / NXCD; wgid = (xcd < r ? xcd * (q + 1) : r * (q + 1) + (xcd - r) * q) + off; }
        const int nig = WGM * nN, gid = wgid / nig, fm = gid * WGM, gsz = (nM - fm) < WGM ? (nM - fm) : WGM;
        u.pm = fm + ((wgid % nig) % gsz); u.pn = (wgid % nig) / gsz; return true;
    }
};

template <class Epi, class Sched>
__device__ __forceinline__ void gemm_phase(LAS unsigned char* lds, const Gemm g, const Sched& S, const Epi& E, int wid) {
    const int lane = lane_id_v(), tid = wid * 64 + lane;
    const int wr = wid >> 2, wc = wid & 3, fr = lane & 15, fq = lane >> 4;
    const int K = g.K, nt = K / BK;
    unsigned voffA[2];
#pragma unroll
    for (int i = 0; i < 2; ++i) { int R, C; stage_rc(tid * 16 + i * 8192, R, C); voffA[i] = (unsigned)(R * K + C) * 2u; }
    const size_t kstep = (size_t)(BK * 2);
    const size_t hstep = (size_t)HALF * K * 2;
    const size_t tstep = 2 * hstep;
    const unsigned ldsw = (unsigned)wid * 1024u;
    const int aoff = lds_byte(wr * 64 + fr, fq * 8), boff = lds_byte(wc * 32 + fr, fq * 8);
#define PG8_SA(b, h) (((b) * 2 + (h)) * HTB)
#define PG8_SB(b, h) ((4 + (b) * 2 + (h)) * HTB)
#define PG8_STAGE(bufoff, gbase) do { _Pragma("unroll") for (int _i = 0; _i < 2; ++_i) \
        __builtin_amdgcn_global_load_lds((const unsigned*)((const char*)(gbase) + voffA[_i]), (LAS unsigned*)(lds + (bufoff) + ldsw + _i * 8192), 16, 0, 0); } while (0)
#define PG8_LDA(dst, b, h) do { _Pragma("unroll") for (int m = 0; m < 4; ++m) _Pragma("unroll") for (int k = 0; k < 2; ++k) dst[m][k] = *(const LAS bf16x8*)(lds + PG8_SA(b, h) + aoff + m * 2048 + k * 1024); } while (0)
#define PG8_LDB(dst, b, h) do { _Pragma("unroll") for (int n = 0; n < 2; ++n) _Pragma("unroll") for (int k = 0; k < 2; ++k) dst[n][k] = *(const LAS bf16x8*)(lds + PG8_SB(b, h) + boff + n * 2048 + k * 1024); } while (0)
#define PG8_MMA(ai, bj, At, Bt) do { __builtin_amdgcn_s_setprio(1); _Pragma("unroll") for (int m = 0; m < 4; ++m) _Pragma("unroll") for (int n = 0; n < 2; ++n) _Pragma("unroll") for (int k = 0; k < 2; ++k) \
        acc[ai][bj][m][n] = __builtin_amdgcn_mfma_f32_16x16x32_bf16(Bt[n][k], At[m][k], acc[ai][bj][m][n], 0, 0, 0); __builtin_amdgcn_s_setprio(0); } while (0)
#define PG8_WAIT_V(n) asm volatile("s_waitcnt vmcnt(" #n ")" ::: "memory")
#define PG8_WAIT_L(n) asm volatile("s_waitcnt lgkmcnt(" #n ")" ::: "memory")
#define PG8_BAR __builtin_amdgcn_s_barrier()
#define PG8_SCHED __builtin_amdgcn_sched_barrier(0)
    Unit cur, nxt; int ui = 0;
    if (!S.next(0, cur)) return;
    f32x4 acc[2][2][4][2];
#pragma unroll
    for (int a = 0; a < 2; ++a)
#pragma unroll
        for (int b = 0; b < 2; ++b)
#pragma unroll
            for (int m = 0; m < 4; ++m)
#pragma unroll
                for (int n = 0; n < 2; ++n) acc[a][b][m][n] = (f32x4){0.f, 0.f, 0.f, 0.f};
    bf16x8 At[4][2], B0[2][2], B1[2][2];
    const char* cA = (const char*)g.A + (size_t)cur.pm * tstep; const char* cB = (const char*)g.Bt + (size_t)cur.pn * tstep;
    PG8_STAGE(PG8_SB(0, 0), cB); PG8_STAGE(PG8_SB(0, 1), cB + hstep); PG8_STAGE(PG8_SA(0, 0), cA); PG8_STAGE(PG8_SA(0, 1), cA + hstep);
    if (wr == 1) PG8_BAR;
    PG8_WAIT_V(2); PG8_BAR;
    PG8_STAGE(PG8_SB(1, 0), cB + kstep); PG8_STAGE(PG8_SA(1, 0), cA + kstep); PG8_STAGE(PG8_SB(1, 1), cB + hstep + kstep);
    PG8_WAIT_V(6); PG8_BAR;
    for (;;) {
        const bool has_next = S.next(ui + 1, nxt);
        const char* nA = has_next ? (const char*)g.A + (size_t)nxt.pm * tstep : cA; const char* nB = has_next ? (const char*)g.Bt + (size_t)nxt.pn * tstep : cB;
        for (int t = 0; t < nt; t += 2) {
            const bool last = (t == nt - 2);
            const char* a1 = cA + (size_t)(t + 1) * kstep;
            const char* a2 = last ? nA : cA + (size_t)(t + 2) * kstep; const char* b2 = last ? nB : cB + (size_t)(t + 2) * kstep;
            const char* a3 = a2 + kstep; const char* b3 = b2 + kstep;
            PG8_LDB(B0, 0, 0); PG8_LDB(B1, 0, 1); PG8_SCHED; PG8_LDA(At, 0, 0); PG8_STAGE(PG8_SA(1, 1), a1 + hstep);
            PG8_WAIT_V(8); PG8_WAIT_L(0); PG8_BAR; PG8_MMA(0, 0, At, B0); PG8_MMA(0, 1, At, B1); PG8_BAR; PG8_SCHED;
            PG8_LDA(At, 0, 1); PG8_STAGE(PG8_SB(0, 0), b2); PG8_STAGE(PG8_SB(0, 1), b2 + hstep); PG8_STAGE(PG8_SA(0, 0), a2);
            PG8_WAIT_V(8); PG8_WAIT_L(0); PG8_BAR; PG8_MMA(1, 0, At, B0); PG8_MMA(1, 1, At, B1); PG8_BAR; PG8_SCHED;
            PG8_LDB(B0, 1, 0); PG8_LDB(B1, 1, 1); PG8_SCHED; PG8_LDA(At, 1, 0); PG8_STAGE(PG8_SA(0, 1), a2 + hstep);
            PG8_WAIT_V(8); PG8_WAIT_L(0); PG8_BAR; PG8_MMA(0, 0, At, B0); PG8_MMA(0, 1, At, B1); PG8_BAR; PG8_SCHED;
            PG8_LDA(At, 1, 1); PG8_STAGE(PG8_SB(1, 0), b3); PG8_STAGE(PG8_SB(1, 1), b3 + hstep); PG8_STAGE(PG8_SA(1, 0), a3);
            PG8_WAIT_V(8); PG8_WAIT_L(0); PG8_BAR; PG8_MMA(1, 0, At, B0); PG8_MMA(1, 1, At, B1); PG8_BAR; PG8_SCHED;
        }
        if (wr == 0) PG8_BAR;
        E(acc, cur, wr, wc, fr, fq);
        if (!has_next) break;
#pragma unroll
        for (int a = 0; a < 2; ++a)
#pragma unroll
            for (int b = 0; b < 2; ++b)
#pragma unroll
                for (int m = 0; m < 4; ++m)
#pragma unroll
                    for (int n = 0; n < 2; ++n) acc[a][b][m][n] = (f32x4){0.f, 0.f, 0.f, 0.f};
        cur = nxt; cA = nA; cB = nB; ++ui;
        if (wr == 1) PG8_BAR;
    }
    PG8_WAIT_V(0);
    PG8_BAR;
#undef PG8_SA
#undef PG8_SB
#undef PG8_STAGE
#undef PG8_LDA
#undef PG8_LDB
#undef PG8_MMA
#undef PG8_WAIT_V
#undef PG8_WAIT_L
#undef PG8_BAR
#undef PG8_SCHED
}

template <class F> struct EpiWrap {
    F f;
    __device__ __forceinline__ void operator()(const f32x4 (&acc)[2][2][4][2], const Unit& u, int wr, int wc, int fr, int fq) const {
#pragma unroll
        for (int bj = 0; bj < 2; ++bj)
#pragma unroll
            for (int n = 0; n < 2; ++n) {
                const int col = u.pn * BM + bj * HALF + wc * 32 + n * 16 + fq * 4;
#pragma unroll
                for (int ai = 0; ai < 2; ++ai)
#pragma unroll
                    for (int m = 0; m < 4; ++m) f(u.pm * BM + ai * HALF + wr * 64 + m * 16 + fr, col, acc[ai][bj][m][n], fq);
            }
    }
};
}

struct FMkv {
    float* out; bf16_t* mkv; int l;
    __device__ __forceinline__ void operator()(int row, int col, f32x4 v, int) const {
        const int c = col;
        *(f32x4*)(out + O5 + ((size_t)l * 2048 + row) * 2048 + c) = v;
        *(u32x2*)(mkv + ((size_t)l * 2048 + row) * 2048 + c) = pk4(v);
    }
};
struct FProj {
    bf16_t *Qb, *Kb, *Vb, *Ub, *Gb; const float* rope; float* out; int l; float* gst;
    __device__ __forceinline__ void kvout(int row, int c, int kv, f32x4 v) const {
        const int head = c >> 6, g = head >> 2, hs = head & 3, dd = c & 63;
        if (row < MP) {
            const int b = row >> 11, t = row & 2047;
            const int win = g == 0 ? 128 : (g == 1 ? 512 : 2048);
            const int tw = t - (2048 - win);
            if (tw >= 0) {
                const size_t base = g == 0 ? O2 : (g == 1 ? O3 : O4);
                *(f32x4*)(out + base + ((((size_t)l * NB + b) * win + tw) * 2 + kv) * 256 + hs * 64 + dd) = v;
            }
        } else if (row < MR) {
            const int r = row - MP;
            const size_t base = g == 0 ? O6 : (g == 1 ? O7 : O8);
            *(f32x4*)(out + base + (((size_t)l * MS + r) * 2 + kv) * 256 + hs * 64 + dd) = v;
        }
    }
    __device__ __forceinline__ void operator()(int row, int col, f32x4 v, int fq, float& s1, float& s2) const {
        if (col < 1536) {
            const bool isk = col >= 768; const int c = isk ? col - 768 : col;
            if ((c & 48) == 0) {
                const int pos = row < MP ? (row & 2047) : 2048 + ((row - MP) & 3);
                const float* rt = rope + pos * 16 + (fq & 1) * 4;
                const f32x4 cs = *(const f32x4*)rt, sn = *(const f32x4*)(rt + 8);
                f32x4 o; o.x = __shfl_xor(v.x, 32); o.y = __shfl_xor(v.y, 32); o.z = __shfl_xor(v.z, 32); o.w = __shfl_xor(v.w, 32);
                if (fq < 2) v = v * cs - o * sn; else v = v * cs + o * sn;
            }
            if (!isk) { *(u32x2*)(Qb + (size_t)row * ATT + c) = pk4(v * QSCALE); }
            else { *(u32x2*)(Kb + (size_t)row * ATT + c) = pk4(v); kvout(row, c, 0, v); }
        } else if (col < 2304) {
            const int c = col - 1536;
            *(u32x2*)(Vb + (size_t)row * ATT + c) = pk4(v); kvout(row, c, 1, v);
        } else {
            f32x4 gl; gl.x = gelu_tanh(v.x); gl.y = gelu_tanh(v.y); gl.z = gelu_tanh(v.z); gl.w = gelu_tanh(v.w);
            if (col < 2560) *(u32x2*)(Ub + (size_t)row * 256 + (col - 2304)) = pk4(gl);
            else { const u32x2 pg = pk4(gl); *(u32x2*)(Gb + (size_t)row * 256 + (col - 2560)) = pg;
                const float z0 = bflo(pg.x), z1 = bfhi(pg.x), z2 = bflo(pg.y), z3 = bfhi(pg.y);
                s1 += (z0 + z1) + (z2 + z3); s2 += (z0 * z0 + z1 * z1) + (z2 * z2 + z3 * z3); }
        }
    }
    __device__ __forceinline__ void finish(const pg8::Unit& u, int wr, int wc, int fr, int fq, float (&s1)[2][4], float (&s2)[2][4]) const {
        if (u.pn != 10) return;
#pragma unroll
        for (int ai = 0; ai < 2; ++ai)
#pragma unroll
            for (int m = 0; m < 4; ++m) {
                float a = s1[ai][m], b = s2[ai][m];
                a += __shfl_xor(a, 16); b += __shfl_xor(b, 16); a += __shfl_xor(a, 32); b += __shfl_xor(b, 32);
                if (fq == 0) { float* p = gst + (size_t)(u.pm * 256 + ai * 128 + wr * 64 + m * 16 + fr) * 8 + wc * 2; p[0] = a; p[1] = b; }
            }
    }
};
__device__ __forceinline__ void stats_main(const float* stm, int row, int fq, float& mu, float& rs) {
    const f32x4* p = (const f32x4*)(stm + (size_t)row * 32 + fq * 8);
    const f32x4 a = p[0], b = p[1];
    float s1 = (a.x + a.z) + (b.x + b.z), s2 = (a.y + a.w) + (b.y + b.w);
    s1 += __shfl_xor(s1, 16); s2 += __shfl_xor(s2, 16); s1 += __shfl_xor(s1, 32); s2 += __shfl_xor(s2, 32);
    mu = s1 * (1.f / DM); rs = __builtin_amdgcn_rsqf(fmaxf(s2 * (1.f / DM) - mu * mu, 0.f) + LN_EPS);
}
__device__ __forceinline__ void stats_sk(const float* sts, int row, int fq, float& mu, float& rs) {
    const f32x4* p = (const f32x4*)(sts + (size_t)(row - MP) * 128 + fq * 32);
    float s1 = 0.f, s2 = 0.f;
#pragma unroll
    for (int i = 0; i < 8; ++i) { const f32x4 a = p[i]; s1 += a.x + a.z; s2 += a.y + a.w; }
    s1 += __shfl_xor(s1, 16); s2 += __shfl_xor(s2, 16); s1 += __shfl_xor(s1, 32); s2 += __shfl_xor(s2, 32);
    mu = s1 * (1.f / DM); rs = __builtin_amdgcn_rsqf(fmaxf(s2 * (1.f / DM) - mu * mu, 0.f) + LN_EPS);
}
template <class F> struct EpiFold {
    F f; bool fold; const float* stm; const float* sts; const float* c1; const float* c2;
    __device__ __forceinline__ void operator()(const f32x4 (&acc)[2][2][4][2], const pg8::Unit& u, int wr, int wc, int fr, int fq) const {
        float mu[2][4], rs[2][4], ps1[2][4], ps2[2][4];
#pragma unroll
        for (int ai = 0; ai < 2; ++ai)
#pragma unroll
            for (int m = 0; m < 4; ++m) { ps1[ai][m] = 0.f; ps2[ai][m] = 0.f; mu[ai][m] = 0.f; rs[ai][m] = 1.f; if (fold) stats_main(stm, u.pm * 256 + ai * 128 + wr * 64 + m * 16 + fr, fq, mu[ai][m], rs[ai][m]); }
#pragma unroll
        for (int bj = 0; bj < 2; ++bj)
#pragma unroll
            for (int n = 0; n < 2; ++n) {
                const int col = u.pn * 256 + bj * 128 + wc * 32 + n * 16 + fq * 4;
                f32x4 c1v = (f32x4){0.f, 0.f, 0.f, 0.f}, c2v = c1v;
                if (fold) { c1v = *(const f32x4*)(c1 + col); c2v = *(const f32x4*)(c2 + col); }
#pragma unroll
                for (int ai = 0; ai < 2; ++ai)
#pragma unroll
                    for (int m = 0; m < 4; ++m) {
                        f32x4 v = acc[ai][bj][m][n];
                        if (fold) v = (v - c1v * mu[ai][m]) * rs[ai][m] + c2v;
                        f(u.pm * 256 + ai * 128 + wr * 64 + m * 16 + fr, col, v, fq, ps1[ai][m], ps2[ai][m]);
                    }
            }
        f.finish(u, wr, wc, fr, fq, ps1, ps2);
    }
    __device__ __forceinline__ void sk(int row, int col, f32x4 v, int fq) const {
        if (fold) { float mu, rs; stats_sk(sts, row, fq, mu, rs); const f32x4 c1v = *(const f32x4*)(c1 + col), c2v = *(const f32x4*)(c2 + col); v = (v - c1v * mu) * rs + c2v; }
        float d1 = 0.f, d2 = 0.f; f(row, col, v, fq, d1, d2);
    }
};
struct EpiRes {
    const bf16_t* src; bf16_t* dst; bool ln; const float* stm_p; const float* sts_p; const float* g; const float* b; float* stm_n; float* sts_n;
    __device__ __forceinline__ void operator()(const f32x4 (&acc)[2][2][4][2], const pg8::Unit& u, int wr, int wc, int fr, int fq) const {
#pragma unroll
        for (int ai = 0; ai < 2; ++ai)
#pragma unroll
            for (int m = 0; m < 4; ++m) {
                const int row = u.pm * 256 + ai * 128 + wr * 64 + m * 16 + fr;
                float mu = 0.f, rs = 1.f; if (ln) stats_main(stm_p, row, fq, mu, rs);
                float s1 = 0.f, s2 = 0.f;
#pragma unroll
                for (int bj = 0; bj < 2; ++bj)
#pragma unroll
                    for (int n = 0; n < 2; ++n) {
                        const int col = u.pn * 256 + bj * 128 + wc * 32 + n * 16 + fq * 4;
                        const u32x2 raw = *(const u32x2*)(src + (size_t)row * DM + col);
                        f32x4 x = (f32x4){bflo(raw.x), bfhi(raw.x), bflo(raw.y), bfhi(raw.y)};
                        if (ln) x = (x - mu) * rs * *(const f32x4*)(g + col) + *(const f32x4*)(b + col);
                        const u32x2 pz = pk4(x * ALPHA + acc[ai][bj][m][n]);
                        *(u32x2*)(dst + (size_t)row * DM + col) = pz;
                        const float z0 = bflo(pz.x), z1 = bfhi(pz.x), z2 = bflo(pz.y), z3 = bfhi(pz.y);
                        s1 += (z0 + z1) + (z2 + z3); s2 += (z0 * z0 + z1 * z1) + (z2 * z2 + z3 * z3);
                    }
                s1 += __shfl_xor(s1, 16); s2 += __shfl_xor(s2, 16); s1 += __shfl_xor(s1, 32); s2 += __shfl_xor(s2, 32);
                if (fq == 0) { float* p = stm_n + (size_t)row * 32 + (u.pn * 4 + wc) * 2; p[0] = s1; p[1] = s2; }
            }
    }
    __device__ __forceinline__ void sk(int row, int col, f32x4 v, int fq) const {
        float mu = 0.f, rs = 1.f; if (ln) stats_sk(sts_p, row, fq, mu, rs);
        const u32x2 raw = *(const u32x2*)(src + (size_t)row * DM + col);
        f32x4 x = (f32x4){bflo(raw.x), bfhi(raw.x), bflo(raw.y), bfhi(raw.y)};
        if (ln) x = (x - mu) * rs * *(const f32x4*)(g + col) + *(const f32x4*)(b + col);
        const u32x2 pz = pk4(x * ALPHA + v);
        *(u32x2*)(dst + (size_t)row * DM + col) = pz;
        const float z0 = bflo(pz.x), z1 = bfhi(pz.x), z2 = bflo(pz.y), z3 = bfhi(pz.y);
        float s1 = (z0 + z1) + (z2 + z3), s2 = (z0 * z0 + z1 * z1) + (z2 * z2 + z3 * z3);
        s1 += __shfl_xor(s1, 16); s2 += __shfl_xor(s2, 16); s1 += __shfl_xor(s1, 32); s2 += __shfl_xor(s2, 32);
        if (fq == 0) { float* p = sts_n + (size_t)(row - MP) * 128 + (col >> 4) * 2; p[0] = s1; p[1] = s2; }
    }
};
struct FScaleBf {
    bf16_t* O; int ldc; float s;
    __device__ __forceinline__ void operator()(int row, int col, f32x4 v, int, float&, float&) const { *(u32x2*)(O + (size_t)row * ldc + col) = pk4(v * s); }
    __device__ __forceinline__ void finish(const pg8::Unit&, int, int, int, int, float (&)[2][4], float (&)[2][4]) const {}
};
struct FRelu2 {
    bf16_t* O;
    __device__ __forceinline__ void finish(const pg8::Unit&, int, int, int, int, float (&)[2][4], float (&)[2][4]) const {}
    __device__ __forceinline__ void operator()(int row, int col, f32x4 v, int, float&, float&) const {
        f32x4 r; r.x = fmaxf(v.x, 0.f); r.y = fmaxf(v.y, 0.f); r.z = fmaxf(v.z, 0.f); r.w = fmaxf(v.w, 0.f);
        *(u32x2*)(O + (size_t)row * FF + col) = pk4(r * r);
    }
};

struct TDesc { const float* W; bf16_t* WT; const float* gsc; const float* bsc; float* cvp; int K, N, item; };
__device__ __forceinline__ void p0_load(const TDesc& d, float (&wv)[32], int lane) {
    const int nblk = d.N / 32, kb = d.item / nblk, nb = d.item % nblk, k0 = 64 * kb, n0 = 32 * nb;
#pragma unroll
    for (int i = 0; i < 32; ++i) wv[i] = d.W[(size_t)(k0 + 2 * i + (lane >> 5)) * d.N + n0 + (lane & 31)];
}
__device__ __forceinline__ void p0_finish(const TDesc& d, float (&wv)[32], LAS float* scr, int lane) {
    const int nblk = d.N / 32, kb = d.item / nblk, nb = d.item % nblk, k0 = 64 * kb, n0 = 32 * nb, K = d.K;
    if (d.gsc) {
        float c1 = 0.f, c2 = 0.f;
#pragma unroll
        for (int i = 0; i < 32; ++i) { const int k = k0 + 2 * i + (lane >> 5); c2 += d.bsc[k] * wv[i]; wv[i] *= d.gsc[k]; c1 += bf2f((unsigned short)f2bf(wv[i])); }
        c1 += __shfl_xor(c1, 32); c2 += __shfl_xor(c2, 32);
        if (lane < 32) { float* p = d.cvp + (size_t)kb * 2 * 4096 + n0 + lane; p[0] = c1; p[4096] = c2; }
    }
#pragma unroll
    for (int i = 0; i < 32; ++i) scr[(2 * i + (lane >> 5)) * 33 + (lane & 31)] = wv[i];
    LDS_WAIT(); asm volatile("" ::: "memory");
    const int c = lane & 7;
#pragma unroll
    for (int j = 0; j < 4; ++j) { const int n = (lane >> 3) + 8 * j; const LAS float* sp = scr + (8 * c) * 33 + n;
        u32x4 o; o.x = pk2(sp[0 * 33], sp[1 * 33]); o.y = pk2(sp[2 * 33], sp[3 * 33]); o.z = pk2(sp[4 * 33], sp[5 * 33]); o.w = pk2(sp[6 * 33], sp[7 * 33]);
        *(u32x4*)(d.WT + (size_t)(n0 + n) * K + k0 + 8 * c) = o; }
    LDS_WAIT(); asm volatile("" ::: "memory");
}

struct Args { const float* in[24]; float* out; unsigned char* ws; int ph_lo, ph_hi; };

__device__ __forceinline__ void final_ln(const bf16_t* ZB, const float* gam, const float* bet, float* yout, int gw, int NGW, int lane) {
    f32x4 gv[4], bv[4];
#pragma unroll
    for (int j = 0; j < 4; ++j) { gv[j] = *(const f32x4*)(gam + 4 * lane + 256 * j); bv[j] = *(const f32x4*)(bet + 4 * lane + 256 * j); }
    for (int row = gw; row < MR; row += NGW) {
        const u32x2* zr = (const u32x2*)(ZB + (size_t)row * DM) + lane;
        f32x4 v[4]; float s = 0.f;
#pragma unroll
        for (int j = 0; j < 4; ++j) { const u32x2 raw = zr[64 * j]; v[j] = (f32x4){bflo(raw.x), bfhi(raw.x), bflo(raw.y), bfhi(raw.y)}; s += (v[j].x + v[j].y) + (v[j].z + v[j].w); }
        const float mean = wave_sum(s) * (1.f / DM); float s2 = 0.f;
#pragma unroll
        for (int j = 0; j < 4; ++j) { v[j] = v[j] - mean; s2 += (v[j].x * v[j].x + v[j].y * v[j].y) + (v[j].z * v[j].z + v[j].w * v[j].w); }
        const float rstd = __builtin_amdgcn_rsqf(wave_sum(s2) * (1.f / DM) + LN_EPS);
        f32x4* o = (f32x4*)(yout + (size_t)row * DM) + lane;
#pragma unroll
        for (int j = 0; j < 4; ++j) o[64 * j] = v[j] * rstd * gv[j] + bv[j];
    }
}

template <bool SAMPLE>
__device__ __forceinline__ void attn_tile(const bf16_t* Qb, const bf16_t* Kb, const bf16_t* Vb, const float* c0, const float* c1, const float* c2, int l,
                                          LAS unsigned char* orow, LAS float* lsep, LAS unsigned char* vl, int b, int h, int rq, int sb, int lane) {
    const int fr = lane & 15, fq = lane >> 4;
    int s0 = 0, r = 0, qi = 0, kt0 = 0;
    const int g = h >> 2, hs = h & 3, dsh = 2 * g;
    const int npre = g == 0 ? 128 : (g == 1 ? 512 : 2048);
    size_t qrow;
    if (SAMPLE) { qi = rq; qrow = (size_t)MP + b * 4 + qi; }
    else { r = rq; s0 = sb * 16; kt0 = sb >= 8 ? 0 : 8 - sb; qrow = (size_t)b * SEQ + (((s0 + fr) << dsh) + r); }
    const float* cbase = SAMPLE ? (g == 0 ? c0 : (g == 1 ? c1 : c2)) + (size_t)(l * DECB + b) * npre * 512 : nullptr;
    const bf16_t* qp = Qb + qrow * ATT + h * 64 + fq * 8;
    const bf16x8 q0 = *(const bf16x8*)qp, q1 = *(const bf16x8*)(qp + 32);
    u32x4 vr[5][4];
#pragma unroll
    for (int kk = 0; kk < 5; ++kk) {
#pragma unroll
        for (int it = 0; it < 4; ++it) vr[kk][it] = (u32x4){0u, 0u, 0u, 0u};
        if (2 * kk + 1 >= kt0) {
#pragma unroll
            for (int it = 0; it < 4; ++it) {
                const int rl = (lane >> 3) + 8 * it, ch = lane & 7;
                u32x4 w;
                if (SAMPLE) {
                    int j = 32 * kk + rl; j = j > 128 ? 128 : j;
                    const int rr = npre + qi - (j << dsh);
                    if (rr >= npre) w = *(const u32x4*)(Vb + ((size_t)MP + b * 4 + (rr - npre)) * ATT + h * 64 + ch * 8);
                    else { const float* vp = cbase + (size_t)rr * 512 + 256 + hs * 64 + ch * 8; const f32x4 a0 = __builtin_nontemporal_load((const f32x4*)vp), a1 = __builtin_nontemporal_load((const f32x4*)(vp + 4));
                        w.x = pk2(a0.x, a0.y); w.y = pk2(a0.z, a0.w); w.z = pk2(a1.x, a1.y); w.w = pk2(a1.z, a1.w); }
                } else {
                    int sk = s0 - 128 + 32 * kk + rl; sk = sk < 0 ? 0 : sk; sk = sk > s0 + 15 ? s0 + 15 : sk;
                    w = *(const u32x4*)(Vb + ((size_t)b * SEQ + ((sk << dsh) + r)) * ATT + h * 64 + ch * 8);
                }
                vr[kk][it] = w;
            }
        }
    }
    f32x4 S[9];
#pragma unroll
    for (int kt = 0; kt < 9; ++kt) {
        S[kt] = (f32x4){-1e30f, -1e30f, -1e30f, -1e30f};
        if (kt >= kt0) {
            bf16x8 k0, k1;
            if (SAMPLE) {
                int j = 16 * kt + fr; j = j > 128 ? 128 : j;
                const int rr = npre + qi - (j << dsh);
                if (rr >= npre) { const bf16_t* kp = Kb + ((size_t)MP + b * 4 + (rr - npre)) * ATT + h * 64 + fq * 8; k0 = *(const bf16x8*)kp; k1 = *(const bf16x8*)(kp + 32); }
                else { const float* kp = cbase + (size_t)rr * 512 + hs * 64 + fq * 8;
                    const f32x4 a0 = __builtin_nontemporal_load((const f32x4*)kp), a1 = __builtin_nontemporal_load((const f32x4*)(kp + 4)), a2 = __builtin_nontemporal_load((const f32x4*)(kp + 32)), a3 = __builtin_nontemporal_load((const f32x4*)(kp + 36));
                    u32x4 w0, w1; w0.x = pk2(a0.x, a0.y); w0.y = pk2(a0.z, a0.w); w0.z = pk2(a1.x, a1.y); w0.w = pk2(a1.z, a1.w);
                    w1.x = pk2(a2.x, a2.y); w1.y = pk2(a2.z, a2.w); w1.z = pk2(a3.x, a3.y); w1.w = pk2(a3.z, a3.w);
                    k0 = __builtin_bit_cast(bf16x8, w0); k1 = __builtin_bit_cast(bf16x8, w1); }
            } else {
                const int sk = s0 - 128 + 16 * kt + fr;
                const bf16_t* kp = Kb + ((size_t)b * SEQ + ((sk << dsh) + r)) * ATT + h * 64 + fq * 8;
                k0 = *(const bf16x8*)kp; k1 = *(const bf16x8*)(kp + 32);
            }
            f32x4 a = (f32x4){0.f, 0.f, 0.f, 0.f};
            a = __builtin_amdgcn_mfma_f32_16x16x32_bf16(k0, q0, a, 0, 0, 0);
            a = __builtin_amdgcn_mfma_f32_16x16x32_bf16(k1, q1, a, 0, 0, 0);
            S[kt] = a;
        }
    }
    if (SAMPLE) {
#pragma unroll
        for (int j = 0; j < 4; ++j) if (4 * fq + j > 0) S[8][j] = -1e30f;
    } else {
#pragma unroll
        for (int j = 0; j < 4; ++j) { if (4 * fq + j < fr) S[0][j] = -1e30f; if (4 * fq + j > fr) S[8][j] = -1e30f; }
    }
    float m = -1e30f;
#pragma unroll
    for (int kt = 0; kt < 9; ++kt) m = fmaxf(m, fmaxf(fmaxf(S[kt].x, S[kt].y), fmaxf(S[kt].z, S[kt].w)));
    m = fmaxf(m, __shfl_xor(m, 16)); m = fmaxf(m, __shfl_xor(m, 32));
    float den = 0.f;
#pragma unroll
    for (int kt = 0; kt < 9; ++kt) { S[kt].x = __builtin_amdgcn_exp2f(S[kt].x - m); S[kt].y = __builtin_amdgcn_exp2f(S[kt].y - m); S[kt].z = __builtin_amdgcn_exp2f(S[kt].z - m); S[kt].w = __builtin_amdgcn_exp2f(S[kt].w - m); den += (S[kt].x + S[kt].y) + (S[kt].z + S[kt].w); }
    den += __shfl_xor(den, 16); den += __shfl_xor(den, 32);
    f32x4 O[4];
#pragma unroll
    for (int n = 0; n < 4; ++n) O[n] = (f32x4){0.f, 0.f, 0.f, 0.f};
    const LAS unsigned char* trp = vl + (4 * fq + (fr >> 2)) * 160 + (lane & 3) * 8;
#pragma unroll
    for (int kk = 0; kk < 5; ++kk) {
        if (2 * kk + 1 >= kt0) {
#pragma unroll
            for (int it = 0; it < 4; ++it) *(LAS u32x4*)(vl + ((lane >> 3) + 8 * it) * 160 + (lane & 7) * 16) = vr[kk][it];
            LDS_WAIT();
            u32x4 pw; pw.x = pk2(S[2 * kk].x, S[2 * kk].y); pw.y = pk2(S[2 * kk].z, S[2 * kk].w);
            if (kk < 4) { pw.z = pk2(S[(2 * kk + 1) % 9].x, S[(2 * kk + 1) % 9].y); pw.w = pk2(S[(2 * kk + 1) % 9].z, S[(2 * kk + 1) % 9].w); } else { pw.z = 0u; pw.w = 0u; }
            const bf16x8 pb = __builtin_bit_cast(bf16x8, pw);
#pragma unroll
            for (int n = 0; n < 4; ++n) {
                const s16x4 lo = vtr(trp + n * 32), hi = vtr(trp + 16 * 160 + n * 32);
                bf16x8 va; va[0] = lo[0]; va[1] = lo[1]; va[2] = lo[2]; va[3] = lo[3]; va[4] = hi[0]; va[5] = hi[1]; va[6] = hi[2]; va[7] = hi[3];
                O[n] = __builtin_amdgcn_mfma_f32_16x16x32_bf16(va, pb, O[n], 0, 0, 0);
            }
            LDS_WAIT();
        }
    }
    const float inv = __builtin_amdgcn_rcpf(den);
    if (!SAMPLE || fr == 0) {
#pragma unroll
        for (int n = 0; n < 4; ++n) *(LAS u32x2*)(orow + 32 * n + 8 * fq) = pk4(O[n] * inv);
        if (fq == 0) *lsep = m * LN2 + __logf(den);
    }
}

#define WG_BAR() do { asm volatile("s_waitcnt lgkmcnt(0)" ::: "memory"); __builtin_amdgcn_s_barrier(); asm volatile("" ::: "memory"); } while (0)
constexpr int XA_BUF = 128 * 544;
template <bool SAMPLE>
__device__ __forceinline__ void xa_load(u32x4 (&r)[8], const bf16_t* MKVl, const float* cmem, int b, int h, int kv, int half, int tid) {
#pragma unroll
    for (int ps = 0; ps < 8; ++ps) {
        const int row = half * 128 + ps * 16 + (tid >> 5), ch = tid & 31;
        if (SAMPLE) { const float* p = cmem + ((size_t)(b * 256 + row) * 2 + kv) * 1024 + h * 256 + ch * 8; const f32x4 a0 = __builtin_nontemporal_load((const f32x4*)p), a1 = __builtin_nontemporal_load((const f32x4*)(p + 4));
            r[ps].x = pk2(a0.x, a0.y); r[ps].y = pk2(a0.z, a0.w); r[ps].z = pk2(a1.x, a1.y); r[ps].w = pk2(a1.z, a1.w); }
        else r[ps] = *(const u32x4*)(MKVl + (size_t)(b * 256 + row) * 2048 + kv * 1024 + h * 256 + ch * 8);
    }
}
__device__ __forceinline__ void xa_load_any(u32x4 (&r)[8], const bf16_t* MKVl, const float* cmem, int u, int tid) {
    if (u < DECB * 4) xa_load<true>(r, MKVl, cmem, u >> 2, u & 3, 0, 0, tid);
    else { const int v = u - DECB * 4; xa_load<false>(r, MKVl, cmem, v >> 6, (v >> 4) & 3, 0, 0, tid); }
}
__device__ __forceinline__ void xa_store(const u32x4 (&r)[8], LAS unsigned char* buf, int stride, int tid) {
#pragma unroll
    for (int ps = 0; ps < 8; ++ps) *(LAS u32x4*)(buf + (ps * 16 + (tid >> 5)) * stride + (tid & 31) * 16) = r[ps];
}
__device__ __forceinline__ void xa_s_half(f32x4* S8, const bf16x8 (&qf)[8], const LAS unsigned char* buf, int fr, int fq) {
    bf16x8 kf[2][8];
    const LAS unsigned char* kbase = buf + fr * 528 + fq * 16;
#pragma unroll
    for (int ks = 0; ks < 8; ++ks) kf[0][ks] = *(const LAS bf16x8*)(kbase + ks * 64);
#pragma unroll
    for (int kt = 0; kt < 8; ++kt) {
        if (kt + 1 < 8) {
#pragma unroll
            for (int ks = 0; ks < 8; ++ks) kf[(kt + 1) & 1][ks] = *(const LAS bf16x8*)(kbase + (kt + 1) * 16 * 528 + ks * 64);
        }
        f32x4 a = (f32x4){0.f, 0.f, 0.f, 0.f};
#pragma unroll
        for (int ks = 0; ks < 8; ++ks) a = __builtin_amdgcn_mfma_f32_16x16x32_bf16(kf[kt & 1][ks], qf[ks], a, 0, 0, 0);
        S8[kt] = a;
        __builtin_amdgcn_sched_barrier(0);
    }
}
template <bool SAMPLE>
__device__ __forceinline__ void xattn_unit(const bf16_t* XQ, const bf16_t* MKVl, const float* cmem, bf16_t* XO, LAS unsigned char* lds, int u, int next, u32x4 (&kpre)[8], int wave) {
    const int lane = lane_id_v(), tid = wave * 64 + lane, fr = lane & 15, fq = lane >> 4;
    int b, h; size_t qrow;
    if (SAMPLE) { b = u >> 2; h = u & 3; qrow = (size_t)MP + b * 4 + (fr & 3); }
    else { const int v = u - DECB * 4; b = v >> 6; h = (v >> 4) & 3; qrow = (size_t)b * SEQ + (v & 15) * 128 + wave * 16 + fr; }
    LAS unsigned char* bufA = lds; LAS unsigned char* bufB = lds + XA_BUF;
    bf16x8 qf[8];
    { const bf16_t* qp = XQ + qrow * DM + h * 256 + fq * 8;
#pragma unroll
      for (int ks = 0; ks < 8; ++ks) qf[ks] = *(const bf16x8*)(qp + 32 * ks); }
    u32x4 r[8];
    xa_load<SAMPLE>(kpre, MKVl, cmem, b, h, 0, 0, tid);
    xa_load<SAMPLE>(r, MKVl, cmem, b, h, 0, 1, tid);
    WG_BAR();
    xa_store(kpre, bufA, 528, tid);
    xa_load<SAMPLE>(kpre, MKVl, cmem, b, h, 1, 0, tid);
    WG_BAR();
    f32x4 S[16];
    xa_s_half(S, qf, bufA, fr, fq);
    xa_store(r, bufB, 528, tid);
    xa_load<SAMPLE>(r, MKVl, cmem, b, h, 1, 1, tid);
    WG_BAR();
    xa_s_half(S + 8, qf, bufB, fr, fq);
    float m = -1e30f;
#pragma unroll
    for (int kt = 0; kt < 16; ++kt) m = fmaxf(m, fmaxf(fmaxf(S[kt].x, S[kt].y), fmaxf(S[kt].z, S[kt].w)));
    m = fmaxf(m, __shfl_xor(m, 16)); m = fmaxf(m, __shfl_xor(m, 32));
    float den = 0.f;
#pragma unroll
    for (int kt = 0; kt < 16; ++kt) { S[kt].x = __builtin_amdgcn_exp2f(S[kt].x - m); S[kt].y = __builtin_amdgcn_exp2f(S[kt].y - m); S[kt].z = __builtin_amdgcn_exp2f(S[kt].z - m); S[kt].w = __builtin_amdgcn_exp2f(S[kt].w - m); den += (S[kt].x + S[kt].y) + (S[kt].z + S[kt].w); }
    den += __shfl_xor(den, 16); den += __shfl_xor(den, 32);
    u32x4 P[8];
#pragma unroll
    for (int kk = 0; kk < 8; ++kk) { P[kk].x = pk2(S[2 * kk].x, S[2 * kk].y); P[kk].y = pk2(S[2 * kk].z, S[2 * kk].w); P[kk].z = pk2(S[2 * kk + 1].x, S[2 * kk + 1].y); P[kk].w = pk2(S[2 * kk + 1].z, S[2 * kk + 1].w); }
    WG_BAR();
    xa_store(kpre, bufA, 544, tid);
    WG_BAR();
    const float inv = 1.f / den;
    constexpr int NO = SAMPLE ? 2 : 16;
    f32x4 O[NO];
#pragma unroll
    for (int n = 0; n < NO; ++n) O[n] = (f32x4){0.f, 0.f, 0.f, 0.f};
    const int trofs = (4 * fq + (fr >> 2)) * 544 + (lane & 3) * 8 + (SAMPLE ? 2 * wave * 32 : 0);
#pragma unroll 1
    for (int hf = 0; hf < 2; ++hf) {
        if (hf == 1) {
            xa_store(r, bufB, 544, tid);
            WG_BAR();
        }
        const LAS unsigned char* trp = (hf ? bufB : bufA) + trofs;
#pragma unroll 1
        for (int kk = 0; kk < 4; ++kk) {
            const int kq = hf * 4 + kk;
            u32x4 pw = P[0];
#pragma unroll
            for (int q = 1; q < 8; ++q) if (kq == q) pw = P[q];
            const bf16x8 pb = __builtin_bit_cast(bf16x8, pw);
#pragma unroll
            for (int n = 0; n < NO; ++n) {
                const s16x4 lo = vtr(trp + kk * 32 * 544 + n * 32), hi = vtr(trp + kk * 32 * 544 + 16 * 544 + n * 32);
                bf16x8 va; va[0] = lo[0]; va[1] = lo[1]; va[2] = lo[2]; va[3] = lo[3]; va[4] = hi[0]; va[5] = hi[1]; va[6] = hi[2]; va[7] = hi[3];
                O[n] = __builtin_amdgcn_mfma_f32_16x16x32_bf16(va, pb, O[n], 0, 0, 0);
            }
        }
    }
    if (SAMPLE) { if (fr < 4) { bf16_t* op = XO + qrow * DM + h * 256 + 32 * wave + 4 * fq; *(u32x2*)op = pk4(O[0] * inv); *(u32x2*)(op + 16) = pk4(O[NO > 1 ? 1 : 0] * inv); } }
    else { bf16_t* op = XO + qrow * DM + h * 256 + 4 * fq;
#pragma unroll
        for (int n = 0; n < NO; ++n) *(u32x2*)(op + 16 * n) = pk4(O[n] * inv); }
}

template <int KSPLIT, class F>
__device__ __forceinline__ void skinny_gemm(const bf16_t* A, const bf16_t* Bt, int N, int K, const F& f, LAS unsigned char* lds, int bx, int G, int wave) {
    const int lane = lane_id_v(), fr = lane & 15, fq = lane >> 4;
    constexpr int MTW = 8 / KSPLIT, RG = 8 / MTW;
    const int ntiles = RG * (N / 16), klen = K / KSPLIT;
    for (int t = bx; t < ntiles; t += G) {
        const int rg = t % RG, n0 = (t / RG) * 16;
        const int mt = rg * MTW + (wave % MTW), kq = wave / MTW;
        const bf16_t* ap = A + (size_t)(MP + 16 * mt + fr) * K + kq * klen + 8 * fq;
        const bf16_t* bp = Bt + (size_t)(n0 + fr) * K + kq * klen + 8 * fq;
        f32x4 acc = (f32x4){0.f, 0.f, 0.f, 0.f};
#pragma unroll 16
        for (int k = 0; k < klen; k += 32) {
            const bf16x8 af = *(const bf16x8*)(ap + k), bf = *(const bf16x8*)(bp + k);
            acc = __builtin_amdgcn_mfma_f32_16x16x32_bf16(bf, af, acc, 0, 0, 0);
        }
        if (KSPLIT > 1) {
            __syncthreads();
            *(LAS f32x4*)(lds + wave * 1024 + lane * 16) = acc;
            __syncthreads();
            if (kq == 0) {
#pragma unroll
                for (int q = 1; q < KSPLIT; ++q) acc = acc + *(const LAS f32x4*)(lds + (wave + q * MTW) * 1024 + lane * 16);
                f.sk(MP + 16 * mt + fr, n0 + 4 * fq, acc, fq);
            }
        } else f.sk(MP + 16 * mt + fr, n0 + 4 * fq, acc, fq);
    }
}

__global__ void __launch_bounds__(NWAVES * 64, 2) mega(Args args) {
    extern __shared__ __attribute__((aligned(16))) unsigned char lds_raw[];
    LAS unsigned char* lds = (LAS unsigned char*)lds_raw;
    const int wave = __builtin_amdgcn_readfirstlane((int)threadIdx.x >> 6);
    const int G = gridDim.x, bx = blockIdx.x;
    const int gw_ = bx * NWAVES + wave, NGW = G * NWAVES;
    unsigned char* ws = args.ws; float* out = args.out;
    float* ROPE = (float*)(ws + WS_ROPE);
    bf16_t* WIN = (bf16_t*)(ws + WS_WIN); bf16_t* WMIX = (bf16_t*)(ws + WS_WMIX); bf16_t* WXQ = (bf16_t*)(ws + WS_WXQ); bf16_t* WXKV = (bf16_t*)(ws + WS_WXKV);
    bf16_t* WXO = (bf16_t*)(ws + WS_WXO); bf16_t* WUP = (bf16_t*)(ws + WS_WUP); bf16_t* WDN = (bf16_t*)(ws + WS_WDN); bf16_t* WSP = (bf16_t*)(ws + WS_WSP);
    bf16_t* MEMB = (bf16_t*)(ws + WS_MEMB); bf16_t* MKV = (bf16_t*)(ws + WS_MKV);
    bf16_t* XB = (bf16_t*)(ws + WS_XB);
    bf16_t* Qb = (bf16_t*)(ws + WS_Q); bf16_t* Kb = (bf16_t*)(ws + WS_K); bf16_t* Vb = (bf16_t*)(ws + WS_V); bf16_t* Ub = (bf16_t*)(ws + WS_U); bf16_t* Gb = (bf16_t*)(ws + WS_G);
    bf16_t* CAT = (bf16_t*)(ws + WS_CAT); float* LSE = (float*)(ws + WS_LSE);
    bf16_t* XQ = (bf16_t*)(ws + WS_XQ); bf16_t* XO = (bf16_t*)(ws + WS_XO); bf16_t* H = (bf16_t*)(ws + WS_H);
    const int lo = args.ph_lo, hi = args.ph_hi;
    int ph = 0;
    cg::grid_group grid = cg::this_grid();
    volatile LAS unsigned* misc = (volatile LAS unsigned*)(lds + LDS_BYTES - 64);
    if (wave == 0) { const int l0 = lane_id_v(); if (l0 < 2) misc[l0] = 0u; }
    __syncthreads();
    XcdBarrier xbar; xbar.bar = g_bar; xbar.x = 0; xbar.st = misc;
    if (hi - lo > 1) xbar = xcd_barrier_post(g_bar, misc, wave);
    if (lo < 0) grid.sync();
#ifndef PHMASK
#define PHMASK 0xFFFF
#endif
#define PON(k) ((PHMASK >> (k)) & 1)
#ifndef REPMASK
#define REPMASK 0
#endif
#define NREP(k) (((REPMASK >> (k)) & 1) ? 2 : 1)
#define RUN (ph >= lo && ph < hi)
#define OPAQ() const int lane = lane_id_v(), tid = wave * 64 + lane; int gw = gw_; asm volatile("" : "+s"(gw)); (void)lane; (void)gw; (void)tid;
#define SEAM() do { if (ph >= lo && ph + 1 < hi) xcd_barrier(xbar, wave); ++ph; } while (0)

    float* CV = (float*)(ws + WS_CV); float* CVP = (float*)(ws + WS_CVP); float* STM = (float*)(ws + WS_STM); float* STS = (float*)(ws + WS_STS); float* GST = (float*)(ws + WS_GST); bf16_t* ZB = (bf16_t*)(ws + WS_ZB);
    if (RUN && PON(0)) for (int rep_ = 0; rep_ < NREP(0); ++rep_) { OPAQ();
        LAS float* scr = (LAS float*)(lds + wave * 16896);
        {
            constexpr int I_IN = 16 * (INC / 32), I_SQ = 16 * 32, I_KV = 16 * 64, I_UP = 16 * 128, I_DN = 64 * 32;
            constexpr int NIT = I_IN + 3 * I_SQ + I_KV + I_UP + I_DN;
            auto mk = [&](int it) -> TDesc {
                const int l = it / NIT; int r = it % NIT; TDesc d; d.gsc = nullptr; d.bsc = nullptr; d.cvp = nullptr; d.K = DM;
                if (r < I_IN) { d.W = args.in[7] + (size_t)l * DM * INC; d.N = INC; d.WT = WIN + (size_t)l * INC * DM; d.item = r;
                    if (l > 0) { d.gsc = args.in[22] + (l - 1) * DM; d.bsc = args.in[23] + (l - 1) * DM; d.cvp = CVP + (size_t)(l * 3 + 0) * 16 * 2 * 4096; } return d; } r -= I_IN;
                if (r < I_SQ) { d.W = args.in[12] + (size_t)l * DM * DM; d.N = DM; d.WT = WMIX + (size_t)l * DM * DM; d.item = r; return d; } r -= I_SQ;
                if (r < I_SQ) { d.W = args.in[15] + (size_t)l * DM * DM; d.N = DM; d.WT = WXQ + (size_t)l * DM * DM; d.item = r;
                    d.gsc = args.in[13] + l * DM; d.bsc = args.in[14] + l * DM; d.cvp = CVP + (size_t)(l * 3 + 1) * 16 * 2 * 4096; return d; } r -= I_SQ;
                if (r < I_SQ) { d.W = args.in[17] + (size_t)l * DM * DM; d.N = DM; d.WT = WXO + (size_t)l * DM * DM; d.item = r; return d; } r -= I_SQ;
                if (r < I_KV) { d.W = args.in[16] + (size_t)l * DM * 2048; d.N = 2048; d.WT = WXKV + (size_t)l * 2048 * DM; d.item = r; return d; } r -= I_KV;
                if (r < I_UP) { d.W = args.in[20] + (size_t)l * DM * FF; d.N = FF; d.WT = WUP + (size_t)l * FF * DM; d.item = r;
                    d.gsc = args.in[18] + l * DM; d.bsc = args.in[19] + l * DM; d.cvp = CVP + (size_t)(l * 3 + 2) * 16 * 2 * 4096; return d; } r -= I_UP;
                d.W = args.in[21] + (size_t)l * FF * DM; d.N = DM; d.K = FF; d.WT = WDN + (size_t)l * DM * FF; d.item = r; return d;
            };
            for (int it = gw; it < DEPTH * NIT; it += 2 * NGW) {
                const bool two = it + NGW < DEPTH * NIT;
                const TDesc da = mk(it), db = mk(two ? it + NGW : it);
                float wa[32], wb[32];
                p0_load(da, wa, lane);
                if (two) p0_load(db, wb, lane);
                p0_finish(da, wa, scr, lane);
                if (two) p0_finish(db, wb, scr + 64 * 33, lane);
            }
        }
#pragma unroll 2
        for (int row = gw; row < MR + 2048; row += NGW) {
            const float* src = row < MP ? args.in[0] + (size_t)row * DM : (row < MR ? args.in[1] + (size_t)(row - MP) * DM : args.in[6] + (size_t)(row - MR) * DM);
            bf16_t* dstp = row < MR ? XB + (size_t)row * DM : MEMB + (size_t)(row - MR) * DM;
            const f32x4* s4 = (const f32x4*)src + lane; u32x2* ob = (u32x2*)dstp + lane;
#pragma unroll
            for (int j = 0; j < 4; ++j) ob[64 * j] = pk4(s4[64 * j]);
        }
        for (int e = bx * 512 + tid; e < DEPTH * 4 * 128 * 128; e += G * 512) { const int s = e & 127, t = (e >> 7) & 127; WSP[e] = s <= t ? (bf16_t)f2bf(args.in[10][e]) : (bf16_t)0; }
        for (int e = bx * 512 + tid; e < 2052 * 8; e += G * 512) {
            const int pi = e >> 3, i = e & 7; const float pos = (float)(pi < 2048 ? pi : 8192 + pi - 2048);
            const float inv = i == 0 ? 1.0f : i == 1 ? 0.19392274474868576f : i == 2 ? 0.03760603093086393f : i == 3 ? 0.007292664737217109f :
                              i == 4 ? 0.001414213562373095f : i == 5 ? 0.0002742481756762073f : i == 6 ? 5.318295896944988e-05f : 1.031338537721246e-05f;
            const float ang = pos * inv;
            const double x = (double)ang, kq = __builtin_rint(x * 0.15915494309189535), rr = (x - kq * 6.283185307179586) , r2 = rr * rr;
            double sn = 0.0, ts = rr, cs = 0.0, tc = 1.0;
            for (int n = 0; n < 16; ++n) { sn += ts; cs += tc; tc *= -r2 / (double)((2 * n + 1) * (2 * n + 2)); ts *= -r2 / (double)((2 * n + 2) * (2 * n + 3)); }
            ROPE[pi * 16 + i] = (float)cs; ROPE[pi * 16 + 8 + i] = (float)sn;
        }
    }
    SEAM();

    int sb = 0;
    for (int l = 0; l < DEPTH; ++l) {
        const float* cvl = CV + (size_t)l * 3 * 2 * 4096;
        if (RUN && PON(1)) for (int rep_ = 0; rep_ < NREP(1); ++rep_) {
            { const bf16_t* Ain = l == 0 ? XB : ZB;
              pg8::Gemm g{Ain, WIN + (size_t)l * INC * DM, MP, INC, DM}; pg8::StaticOrder S; S.init(MP, INC, G, bx);
              EpiFold<FProj> E{FProj{Qb, Kb, Vb, Ub, Gb, ROPE, out, l, GST}, l > 0, STM + (size_t)sb * MP * 32, STS + (size_t)sb * 128 * 128, cvl, cvl + 4096};
              pg8::gemm_phase(lds, g, S, E, wave);
              skinny_gemm<1>(Ain, WIN + (size_t)l * INC * DM, INC, DM, E, lds, G - 1 - bx, G, wave); }
            if (bx >= G - 64) { pg8::Gemm g{MEMB, WXKV + (size_t)l * 2048 * DM, 2048, 2048, DM}; pg8::StaticOrder S; S.init(2048, 2048, 64, bx - (G - 64));
              pg8::EpiWrap<FMkv> E{FMkv{out, MKV, l}};
              pg8::gemm_phase(lds, g, S, E, wave); }
        }
        SEAM();
        if (RUN && PON(2)) for (int rep_ = 0; rep_ < NREP(2); ++rep_) { OPAQ();
            if (l == 0 && rep_ == 0) {
                for (int e = bx * 512 + tid; e < DEPTH * 3 * 2 * 4096; e += G * 512) {
                    const int lw = e / 8192, rem = e % 8192; const float* p = CVP + (size_t)lw * 16 * 8192 + rem; float a = 0.f;
#pragma unroll
                    for (int kb = 0; kb < 16; ++kb) a += p[kb * 8192];
                    CV[e] = a;
                }
            }
            LAS unsigned char* vl = lds + wave * 5120;
            LAS unsigned char* otile = lds + 40960;
            LAS float* lsel = (LAS float*)(lds + 40960 + 98304);
            for (int u = bx; u < DECB * 4; u += G) {
                const int b = u >> 2, hs = u & 3;
                __syncthreads();
                for (int j = wave; j < 12; j += NWAVES) {
                    const int g = j >> 2, qi = j & 3;
                    attn_tile<true>(Qb, Kb, Vb, args.in[2], args.in[3], args.in[4], l, otile + j * 128, lsel + g * 4 + qi, vl, b, g * 4 + hs, qi, 0, lane);
                }
                __syncthreads();
                if (tid < 96) {
                    const int j = tid >> 3, seg = tid & 7, g = j >> 2, qi = j & 3;
                    const float l0 = lsel[qi], l1 = lsel[4 + qi], l2 = lsel[8 + qi], mx = fmaxf(l0, fmaxf(l1, l2));
                    const float e0 = __expf(l0 - mx), e1 = __expf(l1 - mx), e2 = __expf(l2 - mx);
                    const float w = (g == 0 ? e0 : (g == 1 ? e1 : e2)) * __builtin_amdgcn_rcpf(e0 + e1 + e2);
                    const u32x4 v = *(const LAS u32x4*)(otile + j * 128 + seg * 16);
                    u32x4 o; o.x = pk2(bflo(v.x) * w, bfhi(v.x) * w); o.y = pk2(bflo(v.y) * w, bfhi(v.y) * w); o.z = pk2(bflo(v.z) * w, bfhi(v.z) * w); o.w = pk2(bflo(v.w) * w, bfhi(v.w) * w);
                    *(u32x4*)(CAT + ((size_t)MP + b * 4 + qi) * DM + (g * 4 + hs) * 64 + seg * 8) = o;
                }
            }
            for (int u = bx; u < NB * 4 * 8; u += G) {
                const int uu = (G == 256) ? ((u & 7) * 32 + (u >> 3)) : u;
                const int b = uu >> 5, hs = (uu >> 3) & 3, blk = uu & 7;
                __syncthreads();
#pragma unroll 1
                for (int i = 0; i < 6; ++i) {
                    const int j = wave + 8 * i, g = j >> 4, idx = j & 15;
                    const int r = g == 0 ? 0 : (g == 1 ? (idx & 3) : idx), sb = g == 0 ? blk * 16 + idx : (g == 1 ? blk * 4 + (idx >> 2) : blk);
                    const int tk = (((16 * sb + (lane & 15)) << (2 * g)) + r) - 256 * blk;
                    attn_tile<false>(Qb, Kb, Vb, args.in[2], args.in[3], args.in[4], l, otile + (j * 16 + (lane & 15)) * 128, lsel + g * 256 + tk, vl, b, g * 4 + hs, r, sb, lane);
                }
                __syncthreads();
#pragma unroll 2
                for (int p = 0; p < 12; ++p) {
                    const int rowi = (tid >> 3) + 64 * p, seg = tid & 7, j = rowi >> 4, q = rowi & 15, g = j >> 4, idx = j & 15;
                    const int r = g == 0 ? 0 : (g == 1 ? (idx & 3) : idx), sb = g == 0 ? blk * 16 + idx : (g == 1 ? blk * 4 + (idx >> 2) : blk);
                    const int tk = (((16 * sb + q) << (2 * g)) + r) - 256 * blk;
                    const float l0 = lsel[tk], l1 = lsel[256 + tk], l2 = lsel[512 + tk], mx = fmaxf(l0, fmaxf(l1, l2));
                    const float e0 = __expf(l0 - mx), e1 = __expf(l1 - mx), e2 = __expf(l2 - mx);
                    const float w = (g == 0 ? e0 : (g == 1 ? e1 : e2)) * __builtin_amdgcn_rcpf(e0 + e1 + e2);
                    const u32x4 v = *(const LAS u32x4*)(otile + rowi * 128 + seg * 16);
                    u32x4 o; o.x = pk2(bflo(v.x) * w, bfhi(v.x) * w); o.y = pk2(bflo(v.y) * w, bfhi(v.y) * w); o.z = pk2(bflo(v.z) * w, bfhi(v.z) * w); o.w = pk2(bflo(v.w) * w, bfhi(v.w) * w);
                    *(u32x4*)(CAT + ((size_t)b * SEQ + 256 * blk + tk) * DM + (g * 4 + hs) * 64 + seg * 8) = o;
                }
            }
            __syncthreads();
            const float* sg = args.in[8] + l * 256; const float* sb_ = args.in[9] + l * 256;
            for (int b = gw; b < DECB; b += NGW) {
                const f32x4 gg = *(const f32x4*)(sg + 4 * lane), bb = *(const f32x4*)(sb_ + 4 * lane);
                const int g = lane >> 4;
                f32x4 gvv[4];
#pragma unroll
                for (int i = 0; i < 4; ++i) {
                    const size_t row = (size_t)MP + b * 4 + i;
                    const u32x2 raw = *((const u32x2*)(Gb + row * 256) + lane);
                    f32x4 v = (f32x4){bflo(raw.x), bfhi(raw.x), bflo(raw.y), bfhi(raw.y)};
                    const float mean = wave_sum((v.x + v.y) + (v.z + v.w)) * (1.f / 256.f);
                    v = v - mean;
                    const float rstd = __builtin_amdgcn_rsqf(wave_sum((v.x * v.x + v.y * v.y) + (v.z * v.z + v.w * v.w)) * (1.f / 256.f) + LN_EPS);
                    gvv[i] = v * rstd * gg + bb;
                    *(f32x4*)(out + O9 + (((size_t)l * DECB + b) * 4 + i) * 256 + 4 * lane) = gvv[i];
                }
#pragma unroll
                for (int i = 0; i < 4; ++i) {
                    const size_t row = (size_t)MP + b * 4 + i;
                    const float* wsp = args.in[10] + (((size_t)l * 4 + g) * 128 + i) * 128;
                    const float bs = args.in[11][((size_t)l * 4 + g) * 128 + i];
                    f32x4 mx = (f32x4){bs, bs, bs, bs};
#pragma unroll
                    for (int s = 0; s <= i; ++s) mx = mx + gvv[s] * wsp[s];
                    const u32x2 ur = *((const u32x2*)(Ub + row * 256) + lane);
                    f32x4 u = (f32x4){bflo(ur.x), bfhi(ur.x), bflo(ur.y), bfhi(ur.y)};
                    *((u32x2*)(CAT + row * DM + ATT) + lane) = pk4(u * mx);
                }
            }
            const int nsgu = G == 256 ? (bx < 128 ? 1 : 3) : (128 * 4 - bx + G - 1) / G;
            for (int ui = 0; ui < nsgu; ++ui) {
                const int unit = G == 256 ? (bx < 128 ? bx : 128 + 3 * (bx - 128) + ui) : bx + ui * G;
                const int ck = unit >> 2, g = unit & 3; const size_t R0 = (size_t)ck * 128;
                __syncthreads();
                LAS float* stl = (LAS float*)(lds + 24576);
                if (tid < 128) {
                    const f32x4* p = (const f32x4*)(GST + (R0 + tid) * 8); const f32x4 a = p[0], b = p[1];
                    const float s1 = (a.x + a.z) + (b.x + b.z), s2 = (a.y + a.w) + (b.y + b.w);
                    const float mean = s1 * (1.f / 256.f); stl[2 * tid] = mean; stl[2 * tid + 1] = __builtin_amdgcn_rsqf(fmaxf(s2 * (1.f / 256.f) - mean * mean, 0.f) + LN_EPS);
                }
                __syncthreads();
                {
                    const int rr = tid >> 2, cs = (tid & 3) * 16; const float mean = stl[2 * rr], rstd = stl[2 * rr + 1];
                    const u32x4* gp = (const u32x4*)(Gb + (R0 + rr) * 256 + g * 64 + cs);
                    const float* sgp = sg + g * 64 + cs; const float* sbp = sb_ + g * 64 + cs;
#pragma unroll
                    for (int q = 0; q < 2; ++q) {
                        const u32x4 raw = gp[q];
                        const f32x4 g0 = *(const f32x4*)(sgp + 8 * q), g1 = *(const f32x4*)(sgp + 8 * q + 4), b0 = *(const f32x4*)(sbp + 8 * q), b1 = *(const f32x4*)(sbp + 8 * q + 4);
                        const f32x4 v0 = ((f32x4){bflo(raw.x), bfhi(raw.x), bflo(raw.y), bfhi(raw.y)} - mean) * rstd * g0 + b0;
                        const f32x4 v1 = ((f32x4){bflo(raw.z), bfhi(raw.z), bflo(raw.w), bfhi(raw.w)} - mean) * rstd * g1 + b1;
                        u32x4 o; o.x = pk2(v0.x, v0.y); o.y = pk2(v0.z, v0.w); o.z = pk2(v1.x, v1.y); o.w = pk2(v1.z, v1.w);
                        *(LAS u32x4*)(lds + rr * 160 + cs * 2 + q * 16) = o;
                    }
                }
                __syncthreads();
                const int fr = lane & 15, fq = lane >> 4, mt = wave;
                f32x4 acc[4];
#pragma unroll
                for (int n = 0; n < 4; ++n) acc[n] = (f32x4){0.f, 0.f, 0.f, 0.f};
                const bf16_t* wrow = WSP + (((size_t)l * 4 + g) * 128 + 16 * mt + fr) * 128;
                const LAS unsigned char* trp = lds + (4 * fq + (fr >> 2)) * 160 + (lane & 3) * 8;
                for (int sk = 0; sk <= (mt >> 1); ++sk) {
                    const u32x2 w0 = *(const u32x2*)(wrow + 32 * sk + 4 * fq), w1 = *(const u32x2*)(wrow + 32 * sk + 16 + 4 * fq);
                    u32x4 wv; wv.x = w0.x; wv.y = w0.y; wv.z = w1.x; wv.w = w1.y;
                    const bf16x8 wb = __builtin_bit_cast(bf16x8, wv);
#pragma unroll
                    for (int n = 0; n < 4; ++n) {
                        const s16x4 lo = vtr(trp + sk * 32 * 160 + n * 32), hi = vtr(trp + sk * 32 * 160 + 16 * 160 + n * 32);
                        bf16x8 va; va[0] = lo[0]; va[1] = lo[1]; va[2] = lo[2]; va[3] = lo[3]; va[4] = hi[0]; va[5] = hi[1]; va[6] = hi[2]; va[7] = hi[3];
                        acc[n] = __builtin_amdgcn_mfma_f32_16x16x32_bf16(va, wb, acc[n], 0, 0, 0);
                    }
                }
                const int t = 16 * mt + fr; const float bs = args.in[11][((size_t)l * 4 + g) * 128 + t];
#pragma unroll
                for (int n = 0; n < 4; ++n) {
                    const u32x2 ur = *(const u32x2*)(Ub + (R0 + t) * 256 + g * 64 + 16 * n + 4 * fq);
                    const f32x4 u = (f32x4){bflo(ur.x), bfhi(ur.x), bflo(ur.y), bfhi(ur.y)};
                    *(u32x2*)(CAT + (R0 + t) * DM + ATT + g * 64 + 16 * n + 4 * fq) = pk4(u * (acc[n] + bs));
                }
            }
        }
        SEAM();
        if (RUN && PON(4)) for (int rep_ = 0; rep_ < NREP(4); ++rep_) {
            pg8::Gemm g{CAT, WMIX + (size_t)l * DM * DM, MP, DM, DM}; pg8::StaticOrder S; S.init(MP, DM, G, bx);
            EpiRes E{l == 0 ? XB : ZB, ZB, l > 0, STM + (size_t)sb * MP * 32, STS + (size_t)sb * 128 * 128, args.in[22] + (l > 0 ? l - 1 : 0) * DM, args.in[23] + (l > 0 ? l - 1 : 0) * DM,
                     STM + (size_t)(sb ^ 1) * MP * 32, STS + (size_t)(sb ^ 1) * 128 * 128};
            pg8::gemm_phase(lds, g, S, E, wave);
            skinny_gemm<4>(CAT, WMIX + (size_t)l * DM * DM, DM, DM, E, lds, bx, G, wave); }
        SEAM(); sb ^= 1;
        if (RUN && PON(6)) for (int rep_ = 0; rep_ < NREP(6); ++rep_) {
            pg8::Gemm g{ZB, WXQ + (size_t)l * DM * DM, MP, DM, DM}; pg8::StaticOrder S; S.init(MP, DM, G, bx);
            EpiFold<FScaleBf> E{FScaleBf{XQ, DM, XQSCALE}, true, STM + (size_t)sb * MP * 32, STS + (size_t)sb * 128 * 128, cvl + 2 * 4096, cvl + 3 * 4096};
            pg8::gemm_phase(lds, g, S, E, wave);
            skinny_gemm<4>(ZB, WXQ + (size_t)l * DM * DM, DM, DM, E, lds, bx, G, wave); }
        SEAM();
        if (RUN && PON(7)) for (int rep_ = 0; rep_ < NREP(7); ++rep_) { OPAQ();
            const float* cmem = args.in[5] + (size_t)l * DECB * 256 * 2048; const bf16_t* MKVl = MKV + (size_t)l * 2048 * 2048;
            constexpr int NU = DECB * 4 + NB * 4 * 16;
            u32x4 kpre[8];
            if (G == 256) {
                const int xcd = bx & 7, slot = bx >> 3, nun = slot < 16 ? 2 : 3;
                for (int i = 0; i < nun; ++i) {
                    int u;
                    if (slot < 16 && i == 0) u = xcd * 16 + slot;
                    else { const int idx = slot < 16 ? slot : 16 + 3 * (slot - 16) + i; u = DECB * 4 + (xcd + 8 * (idx >> 4)) * 16 + (idx & 15); }
                    if (u < DECB * 4) xattn_unit<true>(XQ, MKVl, cmem, XO, lds, u, -1, kpre, wave);
                    else xattn_unit<false>(XQ, MKVl, cmem, XO, lds, u, -1, kpre, wave);
                }
            } else
            for (int u = bx; u < NU; u += G) {
                if (u < DECB * 4) xattn_unit<true>(XQ, MKVl, cmem, XO, lds, u, -1, kpre, wave);
                else xattn_unit<false>(XQ, MKVl, cmem, XO, lds, u, -1, kpre, wave);
            }
            __syncthreads();
        }
        SEAM();
        if (RUN && PON(8)) for (int rep_ = 0; rep_ < NREP(8); ++rep_) {
            pg8::Gemm g{XO, WXO + (size_t)l * DM * DM, MP, DM, DM}; pg8::StaticOrder S; S.init(MP, DM, G, bx);
            EpiRes E{ZB, ZB, true, STM + (size_t)sb * MP * 32, STS + (size_t)sb * 128 * 128, args.in[13] + l * DM, args.in[14] + l * DM,
                     STM + (size_t)(sb ^ 1) * MP * 32, STS + (size_t)(sb ^ 1) * 128 * 128};
            pg8::gemm_phase(lds, g, S, E, wave);
            skinny_gemm<4>(XO, WXO + (size_t)l * DM * DM, DM, DM, E, lds, bx, G, wave); }
        SEAM(); sb ^= 1;
        if (RUN && PON(10)) for (int rep_ = 0; rep_ < NREP(10); ++rep_) {
            pg8::Gemm g{ZB, WUP + (size_t)l * FF * DM, MP, FF, DM}; pg8::StaticOrder S; S.init(MP, FF, G, bx);
            EpiFold<FRelu2> E{FRelu2{H}, true, STM + (size_t)sb * MP * 32, STS + (size_t)sb * 128 * 128, cvl + 4 * 4096, cvl + 5 * 4096};
            pg8::gemm_phase(lds, g, S, E, wave);
            skinny_gemm<1>(ZB, WUP + (size_t)l * FF * DM, FF, DM, E, lds, bx, G, wave); }
        SEAM();
        if (RUN && PON(11)) for (int rep_ = 0; rep_ < NREP(11); ++rep_) {
            pg8::Gemm g{H, WDN + (size_t)l * DM * FF, MP, DM, FF}; pg8::StaticOrder S; S.init(MP, DM, G, bx);
            EpiRes E{ZB, ZB, true, STM + (size_t)sb * MP * 32, STS + (size_t)sb * 128 * 128, args.in[18] + l * DM, args.in[19] + l * DM,
                     STM + (size_t)(sb ^ 1) * MP * 32, STS + (size_t)(sb ^ 1) * 128 * 128};
            pg8::gemm_phase(lds, g, S, E, wave);
            skinny_gemm<4>(H, WDN + (size_t)l * DM * FF, DM, FF, E, lds, bx, G, wave); }
        SEAM(); sb ^= 1;
    }
    if (RUN && PON(12)) for (int rep_ = 0; rep_ < NREP(12); ++rep_) { OPAQ(); final_ln(ZB, args.in[22] + (DEPTH - 1) * DM, args.in[23] + (DEPTH - 1) * DM, out, gw, NGW, lane); }
    SEAM();
    if (hi - lo > 1) {
        __syncthreads();
        if (wave == 0 && lane_id_v() == 0) {
            const unsigned old = xb_add(&g_bar[XB_DONE], 1u);
            if (old + 1u == (unsigned)G) {
#pragma unroll 1
                for (int j = 0; j < 16; ++j) {
                    __hip_atomic_store(&g_bar[XB_XCNT(j)], 0u, __ATOMIC_RELAXED, __HIP_MEMORY_SCOPE_AGENT);
                    __hip_atomic_store(&g_bar[XB_XSUB(j)], 0u, __ATOMIC_RELAXED, __HIP_MEMORY_SCOPE_AGENT);
                    __hip_atomic_store(&g_bar[XB_XGEN(j)], 0u, __ATOMIC_RELAXED, __HIP_MEMORY_SCOPE_AGENT);
                }
                __hip_atomic_store(&g_bar[XB_TOP], 0u, __ATOMIC_RELAXED, __HIP_MEMORY_SCOPE_AGENT);
                __hip_atomic_store(&g_bar[XB_TOPGEN], 0u, __ATOMIC_RELAXED, __HIP_MEMORY_SCOPE_AGENT);
                __hip_atomic_store(&g_bar[XB_TMO], 0u, __ATOMIC_RELAXED, __HIP_MEMORY_SCOPE_AGENT);
                __hip_atomic_store(&g_bar[XB_DONE], 0u, __ATOMIC_RELAXED, __HIP_MEMORY_SCOPE_AGENT);
            }
        }
    }
#undef RUN
#undef SEAM
}
constexpr int N_PHASES = 2 + DEPTH * 8;

extern "C" void kernel_launch(void* const* d_in, const int* in_sizes, int n_in, void* d_out, int out_size, void* d_ws, size_t ws_size, hipStream_t stream) {
    static int grid = 0;
    if (grid == 0) {
        if (n_in != 24 || ws_size < WS_END) { fprintf(stderr, "kernel_launch: need 24 inputs and %zu bytes of ws (got %d, %zu)\n", (size_t)WS_END, n_in, ws_size); grid = -1; return; }
        int dev = 0, cus = 0, per_cu = 0;
        hipGetDevice(&dev); hipDeviceGetAttribute(&cus, hipDeviceAttributeMultiprocessorCount, dev);
        if (hipFuncSetAttribute((const void*)mega, hipFuncAttributeMaxDynamicSharedMemorySize, LDS_BYTES) != hipSuccess) { fprintf(stderr, "kernel_launch: hipFuncSetAttribute failed\n"); grid = -1; return; }
        hipOccupancyMaxActiveBlocksPerMultiprocessor(&per_cu, (const void*)mega, NWAVES * 64, LDS_BYTES);
        if (per_cu < 1) { fprintf(stderr, "kernel_launch: occupancy query says %d blocks/CU\n", per_cu); per_cu = 1; }
        (void)hipGetLastError();
        grid = cus * 1;
    }
    if (grid < 0) return;
    Args a{};
    for (int i = 0; i < 24; ++i) a.in[i] = (const float*)d_in[i];
    a.out = (float*)d_out; a.ws = (unsigned char*)d_ws;
#if MK_MULTI
    for (int p = 0; p < N_PHASES; ++p) {
        a.ph_lo = p; a.ph_hi = p + 1;
        hipLaunchKernelGGL(mega, dim3(grid), dim3(NWAVES * 64), LDS_BYTES, stream, a);
    }
#else
    a.ph_lo = 0; a.ph_hi = N_PHASES;
    void* kargs[] = {&a};
    hipError_t e = hipLaunchCooperativeKernel((const void*)mega, dim3(grid), dim3(NWAVES * 64), kargs, LDS_BYTES, stream);
    if (e != hipSuccess) fprintf(stderr, "cooperative launch failed: %s (grid %d)\n", hipGetErrorString(e), grid);
#endif
}
```
